# Optimizing an MI355X kernel written in HIP

```python
import math
import jax
import jax.numpy as jnp
from jax import lax
import numpy as np

D_MODEL = 1024
BATCH = 8
SEQ = 2048
DEPTH = 2

GRID_W = 64
CTX_LEN = 256
HEAD_DIM = 64
GROUP_HEADS = 4
GROUP_WIDTH = GROUP_HEADS * HEAD_DIM
N_MIXERS = 4
MIX_WIDTH = N_MIXERS * GROUP_WIDTH
KV_HEADS = 2
KV_GROUPS = GROUP_HEADS // KV_HEADS
KV_WIDTH = KV_HEADS * HEAD_DIM
GDN_CONV = 3
GDN_CHUNK = 64
HGRN_CHUNK = 16
Q_BLOCK = 128
WINDOW = 128
ROPE_THETA = 10000.0
D_FF = 2816
FFN_CONV = 3
N_MOD = 6
EPS = 1e-6
NEG = -1e30
F32 = jnp.float32

IN_SIZES = (
    3 * GROUP_WIDTH,
    GROUP_WIDTH,
    2 * GROUP_HEADS,
    2 * GROUP_HEADS,
    GROUP_WIDTH,
    2 * KV_WIDTH,
    GROUP_WIDTH,
    2 * KV_WIDTH,
    GROUP_WIDTH,
    2 * GROUP_WIDTH,
    GROUP_WIDTH,
    GROUP_WIDTH,
)
IN_WIDTH = sum(IN_SIZES)

kernel_name = 'hybrid_parallel_heads_dit_block'


def rms_norm(x, gain):
    xf = x.astype(F32)
    y = xf * lax.rsqrt(jnp.mean(xf * xf, axis=-1, keepdims=True) + EPS)
    return (y * gain.astype(F32)).astype(x.dtype)


def l2_normalize(x):
    xf = x.astype(F32)
    return xf * lax.rsqrt(jnp.sum(xf * xf, axis=-1, keepdims=True) + EPS)


def split_heads(x, n_heads):
    b, length, _ = x.shape
    return x.reshape(b, length, n_heads, -1).transpose(0, 2, 1, 3)


def merge_heads(x):
    b, n, length, d = x.shape
    return x.transpose(0, 2, 1, 3).reshape(b, length, n * d)


def modulate(x, shift, scale):
    return x * (1.0 + scale) + shift


def split_columns(p):
    offsets = np.cumsum(IN_SIZES)[:-1].tolist()
    return jnp.split(p, offsets, axis=-1)


def dwconv_centered(x, w, b=None):
    k_width = w.shape[0]
    pad = k_width // 2
    length = x.shape[1]
    xp = jnp.pad(x, ((0, 0), (pad, pad), (0, 0)))
    y = xp[:, 0:length] * w[0]
    for j in range(1, k_width):
        y = y + xp[:, j:j + length] * w[j]
    return y if b is None else y + b


def axial_rope_tables(rows):
    row = jnp.repeat(jnp.arange(rows), GRID_W).astype(F32)
    col = jnp.tile(jnp.arange(GRID_W), rows).astype(F32)
    n_freq = HEAD_DIM // 4
    inv_freq = 1.0 / (ROPE_THETA ** (jnp.arange(n_freq, dtype=F32) / n_freq))
    ang = jnp.concatenate([row[:, None] * inv_freq, col[:, None] * inv_freq], axis=-1)
    return jnp.cos(ang), jnp.sin(ang)


def apply_rope(x, cos, sin):
    xf = x.astype(F32).reshape(x.shape[:-1] + (HEAD_DIM // 2, 2))
    x0, x1 = xf[..., 0], xf[..., 1]
    out = jnp.stack([x0 * cos - x1 * sin, x0 * sin + x1 * cos], axis=-1)
    return out.reshape(x.shape).astype(x.dtype)


def bidirectional_scan(scan_fn, ctx_fwd, ctx_bwd, lat_fwd, lat_bwd, s0):
    rev = lambda args: tuple(jnp.flip(a, axis=2) for a in args)
    o_cf, s_cf = scan_fn(*ctx_fwd, s0)
    o_lf, _ = scan_fn(*lat_fwd, s_cf)
    o_cb, s_cb = scan_fn(*rev(ctx_bwd), s0)
    o_lb, _ = scan_fn(*rev(lat_bwd), s_cb)
    return o_cf + jnp.flip(o_cb, axis=2), o_lf + jnp.flip(o_lb, axis=2)


def gdn_chunked(q, k, v, g, beta, s0):
    b, h, length, dk = q.shape
    dv = v.shape[-1]
    cs = GDN_CHUNK
    n = length // cs
    q = q.reshape(b, h, n, cs, dk)
    k = k.reshape(b, h, n, cs, dk)
    v = v.reshape(b, h, n, cs, dv)
    beta = beta.reshape(b, h, n, cs)
    gc = jnp.cumsum(g.reshape(b, h, n, cs), axis=-1)
    incl = jnp.tril(jnp.ones((cs, cs), bool))
    strict = jnp.tril(jnp.ones((cs, cs), bool), -1)
    decay = jnp.exp(jnp.where(incl, gc[..., :, None] - gc[..., None, :], NEG))
    kb = k * beta[..., None]
    m = jnp.where(strict, jnp.einsum('bhnid,bhnjd->bhnij', kb, k) * decay, 0.0)
    a = m + jnp.eye(cs, dtype=F32)
    rhs = jnp.concatenate([v * beta[..., None], kb * jnp.exp(gc)[..., None]], axis=-1)
    sol = lax.linalg.triangular_solve(a, rhs, left_side=True, lower=True, unit_diagonal=True)
    u, w = sol[..., :dv], sol[..., dv:]
    attn = jnp.einsum('bhnid,bhnjd->bhnij', q, k) * decay
    q_dec = q * jnp.exp(gc)[..., None]
    k_dec = k * jnp.exp(gc[..., -1:] - gc)[..., None]
    g_last = jnp.exp(gc[..., -1])

    def step(state, xs):
        u_i, w_i, qd_i, kd_i, at_i, gl_i = xs
        v_new = u_i - jnp.einsum('bhcd,bhde->bhce', w_i, state)
        o_i = jnp.einsum('bhcd,bhde->bhce', qd_i, state) + jnp.einsum('bhij,bhje->bhie', at_i, v_new)
        state = state * gl_i[..., None, None] + jnp.einsum('bhcd,bhce->bhde', kd_i, v_new)
        return state, o_i

    xs = tuple(jnp.moveaxis(t, 2, 0) for t in (u, w, q_dec, k_dec, attn, g_last))
    s_fin, o = lax.scan(step, s0, xs)
    return jnp.moveaxis(o, 0, 2).reshape(b, h, length, dv), s_fin


def hgrn_chunked(q, k, v, log_f, s0):
    b, h, length, dk = q.shape
    dv = v.shape[-1]
    cs = HGRN_CHUNK
    n = length // cs
    q = q.reshape(b, h, n, cs, dk)
    k = k.reshape(b, h, n, cs, dk)
    v = v.reshape(b, h, n, cs, dv)
    bc = jnp.cumsum(log_f.reshape(b, h, n, cs, dk), axis=3)
    incl = jnp.tril(jnp.ones((cs, cs), bool))[:, :, None]
    rel = bc[:, :, :, :, None, :] - bc[:, :, :, None, :, :]
    decay = jnp.exp(jnp.where(incl, rel, NEG))
    attn = jnp.einsum('bhnid,bhnjd,bhnijd->bhnij', q, k, decay)
    q_dec = q * jnp.exp(bc)
    k_dec = k * jnp.exp(bc[:, :, :, -1:] - bc)
    f_last = jnp.exp(bc[:, :, :, -1])

    def step(state, xs):
        qd_i, kd_i, v_i, at_i, fl_i = xs
        o_i = jnp.einsum('bhcd,bhde->bhce', qd_i, state) + jnp.einsum('bhij,bhje->bhie', at_i, v_i)
        state = state * fl_i[..., None] + jnp.einsum('bhcd,bhce->bhde', kd_i, v_i)
        return state, o_i

    xs = tuple(jnp.moveaxis(t, 2, 0) for t in (q_dec, k_dec, v, attn, f_last))
    s_fin, o = lax.scan(step, s0, xs)
    return jnp.moveaxis(o, 0, 2).reshape(b, h, length, dv), s_fin


def gdn_mixer(qkv_c, z_c, beta_c, a_c, qkv_l, z_l, beta_l, a_l, conv_w, a_log, dt_bias, o_gain):
    def prep(qkv, beta_raw, a_raw):
        b, length, _ = qkv.shape
        qkv = jax.nn.silu(dwconv_centered(qkv, conv_w))
        q, k, v = jnp.split(qkv, 3, axis=-1)
        q = l2_normalize(split_heads(q, GROUP_HEADS)) * HEAD_DIM ** -0.5
        k = l2_normalize(split_heads(k, GROUP_HEADS))
        v = split_heads(v, GROUP_HEADS).astype(F32)
        beta = jax.nn.sigmoid(beta_raw.astype(F32)).reshape(b, length, 2, GROUP_HEADS).transpose(2, 0, 3, 1)
        a = a_raw.astype(F32).reshape(b, length, 2, GROUP_HEADS) + dt_bias.astype(F32)
        g = (-jnp.exp(a_log.astype(F32)) * jax.nn.softplus(a)).transpose(2, 0, 3, 1)
        return q, k, v, g, beta

    qc, kc, vc, gc, bc = prep(qkv_c, beta_c, a_c)
    ql, kl, vl, gl, bl = prep(qkv_l, beta_l, a_l)
    s0 = jnp.zeros((qkv_l.shape[0], GROUP_HEADS, HEAD_DIM, HEAD_DIM), F32)
    o_c, o_l = bidirectional_scan(gdn_chunked,
                                  (qc, kc, vc, gc[0], bc[0]), (qc, kc, vc, gc[1], bc[1]),
                                  (ql, kl, vl, gl[0], bl[0]), (ql, kl, vl, gl[1], bl[1]), s0)

    def out(o, z):
        gate = jax.nn.silu(split_heads(z, GROUP_HEADS).astype(F32))
        return merge_heads(rms_norm(o, o_gain) * gate).astype(z.dtype)

    return out(o_c, z_c), out(o_l, z_l)


def softmax_attend(q, k, v):
    s = jnp.einsum('bkgqd,bksd->bkgqs', q, k).astype(F32) * HEAD_DIM ** -0.5
    p = jax.nn.softmax(s, axis=-1).astype(v.dtype)
    return jnp.einsum('bkgqs,bksd->bkgqd', p, v)


def global_gqa(q_c, kv_c, q_l, kv_l, q_gain, k_gain, cos, sin, with_ctx):
    b, length, _ = q_l.shape
    k_c, v_c = jnp.split(kv_c, 2, axis=-1)
    k_l, v_l = jnp.split(kv_l, 2, axis=-1)
    k_c = rms_norm(split_heads(k_c, KV_HEADS), k_gain)
    v_c = split_heads(v_c, KV_HEADS)
    k_l = apply_rope(rms_norm(split_heads(k_l, KV_HEADS), k_gain), cos, sin)
    v_l = split_heads(v_l, KV_HEADS)
    q_l = apply_rope(rms_norm(split_heads(q_l, GROUP_HEADS), q_gain), cos, sin)
    keys = jnp.concatenate([k_c, k_l], axis=2)
    vals = jnp.concatenate([v_c, v_l], axis=2)
    nb = length // Q_BLOCK
    qb = jnp.moveaxis(q_l.reshape(b, KV_HEADS, KV_GROUPS, nb, Q_BLOCK, HEAD_DIM), 3, 0)
    o_l = lax.map(lambda q_blk: softmax_attend(q_blk, keys, vals), qb)
    o_l = merge_heads(jnp.moveaxis(o_l, 0, 3).reshape(b, GROUP_HEADS, length, HEAD_DIM))
    if not with_ctx:
        return None, o_l
    qc = rms_norm(split_heads(q_c, GROUP_HEADS), q_gain).reshape(b, KV_HEADS, KV_GROUPS, -1, HEAD_DIM)
    o_c = softmax_attend(qc, k_c, v_c).reshape(b, GROUP_HEADS, -1, HEAD_DIM)
    return merge_heads(o_c), o_l


def window_gqa(q_c, kv_c, q_l, kv_l, sink, cos, sin, with_ctx):
    b, length, _ = q_l.shape
    nb = length // Q_BLOCK
    scale = HEAD_DIM ** -0.5
    k_c, v_c = jnp.split(kv_c, 2, axis=-1)
    k_l, v_l = jnp.split(kv_l, 2, axis=-1)
    k_c = split_heads(k_c, KV_HEADS)
    v_c = split_heads(v_c, KV_HEADS)
    k_l = apply_rope(split_heads(k_l, KV_HEADS), cos, sin)
    v_l = split_heads(v_l, KV_HEADS)
    q_l = apply_rope(split_heads(q_l, GROUP_HEADS), cos, sin)

    def band(t):
        tp = jnp.pad(t, ((0, 0), (0, 0), (Q_BLOCK, Q_BLOCK), (0, 0))).reshape(b, KV_HEADS, nb + 2, Q_BLOCK, HEAD_DIM)
        return jnp.concatenate([tp[:, :, :-2], tp[:, :, 1:-1], tp[:, :, 2:]], axis=3)

    k_band, v_band = band(k_l), band(v_l)
    qb = q_l.reshape(b, KV_HEADS, KV_GROUPS, nb, Q_BLOCK, HEAD_DIM)
    s_band = jnp.einsum('bkgnqd,bknsd->bkgnqs', qb, k_band).astype(F32) * scale
    blk = jnp.arange(nb)[:, None, None]
    q_pos = blk * Q_BLOCK + jnp.arange(Q_BLOCK)[None, :, None]
    k_pos = (blk - 1) * Q_BLOCK + jnp.arange(3 * Q_BLOCK)[None, None, :]
    valid = (jnp.abs(q_pos - k_pos) <= WINDOW) & (k_pos >= 0) & (k_pos < length)
    s_band = jnp.where(valid, s_band, NEG)
    s_ctx = jnp.einsum('bkgnqd,bksd->bkgnqs', qb, k_c).astype(F32) * scale
    sink_col = jnp.broadcast_to(sink.astype(F32).reshape(1, KV_HEADS, KV_GROUPS, 1, 1, 1), s_band.shape[:-1] + (1,))
    p = jax.nn.softmax(jnp.concatenate([s_band, s_ctx, sink_col], axis=-1), axis=-1).astype(v_l.dtype)
    n_band = 3 * Q_BLOCK
    n_ctx = k_c.shape[2]
    o_l = (jnp.einsum('bkgnqs,bknsd->bkgnqd', p[..., :n_band], v_band)
           + jnp.einsum('bkgnqs,bksd->bkgnqd', p[..., n_band:n_band + n_ctx], v_c))
    o_l = merge_heads(o_l.reshape(b, GROUP_HEADS, length, HEAD_DIM))
    if not with_ctx:
        return None, o_l
    qc = split_heads(q_c, GROUP_HEADS).reshape(b, KV_HEADS, KV_GROUPS, -1, HEAD_DIM)
    s_c = jnp.einsum('bkgqd,bksd->bkgqs', qc, k_c).astype(F32) * scale
    sink_c = jnp.broadcast_to(sink.astype(F32).reshape(1, KV_HEADS, KV_GROUPS, 1, 1), s_c.shape[:-1] + (1,))
    p_c = jax.nn.softmax(jnp.concatenate([s_c, sink_c], axis=-1), axis=-1)[..., :-1].astype(v_c.dtype)
    o_c = jnp.einsum('bkgqs,bksd->bkgqd', p_c, v_c).reshape(b, GROUP_HEADS, -1, HEAD_DIM)
    return merge_heads(o_c), o_l


def hgrn_mixer(q_c, f_c, i_c, g_c, q_l, f_l, i_l, g_l, lower_bound, o_gain):
    def prep(q, f, i):
        b, length, _ = q.shape
        q = split_heads(jax.nn.silu(q), GROUP_HEADS).astype(F32)
        v = split_heads(i, GROUP_HEADS).astype(F32)
        z = f.astype(F32).reshape(b, length, 2, GROUP_WIDTH)
        f_gate = lower_bound + (1.0 - lower_bound) * jax.nn.sigmoid(z)
        log_f = jnp.log(f_gate)
        log_f = log_f.reshape(b, length, 2, GROUP_HEADS, HEAD_DIM).transpose(2, 0, 3, 1, 4)
        k = -jnp.expm1(log_f)
        return q, v, k, log_f

    qc, vc, kc, lfc = prep(q_c, f_c, i_c)
    ql, vl, kl, lfl = prep(q_l, f_l, i_l)
    s0 = jnp.zeros((q_l.shape[0], GROUP_HEADS, HEAD_DIM, HEAD_DIM), F32)
    o_c, o_l = bidirectional_scan(hgrn_chunked,
                                  (qc, kc[0], vc, lfc[0]), (qc, kc[1], vc, lfc[1]),
                                  (ql, kl[0], vl, lfl[0]), (ql, kl[1], vl, lfl[1]), s0)

    def out(o, g):
        gate = jax.nn.silu(split_heads(g, GROUP_HEADS).astype(F32))
        return merge_heads(rms_norm(o, o_gain) * gate).astype(g.dtype)

    return out(o_c, g_c), out(o_l, g_l)


def token_mixing(h_c, h_l, w_in, w_out, gdn_conv_w, gdn_a_log, gdn_dt_bias, gdn_norm,
                 attn_q_norm, attn_k_norm, swa_sink, hgrn_lb, hgrn_norm, cos, sin, with_ctx):
    pc = split_columns(h_c @ w_in)
    pl = split_columns(h_l @ w_in)
    a_c, a_l = gdn_mixer(*pc[0:4], *pl[0:4], gdn_conv_w, gdn_a_log, gdn_dt_bias, gdn_norm)
    b_c, b_l = global_gqa(pc[4], pc[5], pl[4], pl[5], attn_q_norm, attn_k_norm, cos, sin, with_ctx)
    c_c, c_l = window_gqa(pc[6], pc[7], pl[6], pl[7], swa_sink, cos, sin, with_ctx)
    d_c, d_l = hgrn_mixer(*pc[8:12], *pl[8:12], hgrn_lb, hgrn_norm)
    o_l = jnp.concatenate([a_l, b_l, c_l, d_l], axis=-1) @ w_out
    if not with_ctx:
        return None, o_l
    o_c = jnp.concatenate([a_c, b_c, c_c, d_c], axis=-1) @ w_out
    return o_c, o_l


def conv_ffn(h, w_up, conv_w, conv_b, w_down):
    u = dwconv_centered(h @ w_up, conv_w, conv_b)
    gate, val = jnp.split(u, 2, axis=-1)
    return (jax.nn.silu(gate) * val) @ w_down


def setup_inputs(seed: int = 0) -> dict:
    key = jax.random.key(seed)
    ks = jax.random.split(key, 25)

    def normal(k, shape, scale):
        return jax.random.normal(k, shape, F32) * scale

    def gain(k, shape):
        return 1.0 + 0.05 * jax.random.normal(k, shape, F32)

    dt = jnp.exp(jax.random.uniform(ks[14], (DEPTH, 2, GROUP_HEADS), F32, math.log(1e-3), math.log(1e-1)))
    return {
        'x': normal(ks[0], (BATCH, SEQ, D_MODEL), 1.0),
        'c': normal(ks[1], (BATCH, D_MODEL), 1.0),
        'ctx': normal(ks[2], (BATCH, CTX_LEN, D_MODEL), 1.0),
        'c_ctx': normal(ks[3], (D_MODEL,), 1.0),
        'ada_w': normal(ks[4], (DEPTH, D_MODEL, N_MOD * D_MODEL), D_MODEL ** -0.5),
        'ada_b': normal(ks[5], (DEPTH, N_MOD * D_MODEL), 0.02),
        'norm_pre_mix': gain(ks[6], (DEPTH, D_MODEL)),
        'norm_post_mix': gain(ks[7], (DEPTH, D_MODEL)),
        'norm_pre_ffn': gain(ks[8], (DEPTH, D_MODEL)),
        'norm_post_ffn': gain(ks[9], (DEPTH, D_MODEL)),
        'w_in': normal(ks[10], (DEPTH, D_MODEL, IN_WIDTH), D_MODEL ** -0.5),
        'w_out': normal(ks[11], (DEPTH, MIX_WIDTH, D_MODEL), MIX_WIDTH ** -0.5),
        'gdn_conv_w': normal(ks[12], (DEPTH, GDN_CONV, 3 * GROUP_WIDTH), GDN_CONV ** -0.5),
        'gdn_a_log': jnp.log(jax.random.uniform(ks[13], (DEPTH, 2, GROUP_HEADS), F32, 1.0, 16.0)),
        'gdn_dt_bias': dt + jnp.log(-jnp.expm1(-dt)),
        'gdn_norm': gain(ks[15], (DEPTH, HEAD_DIM)),
        'attn_q_norm': gain(ks[16], (DEPTH, HEAD_DIM)),
        'attn_k_norm': gain(ks[17], (DEPTH, HEAD_DIM)),
        'swa_sink': normal(ks[18], (DEPTH, GROUP_HEADS), 0.5),
        'hgrn_lb_raw': normal(ks[19], (DEPTH, 2, GROUP_WIDTH), 0.5),
        'hgrn_norm': gain(ks[20], (DEPTH, HEAD_DIM)),
        'ffn_w_up': normal(ks[21], (DEPTH, D_MODEL, 2 * D_FF), D_MODEL ** -0.5),
        'ffn_conv_w': normal(ks[22], (DEPTH, FFN_CONV, 2 * D_FF), FFN_CONV ** -0.5),
        'ffn_conv_b': normal(ks[23], (DEPTH, 2 * D_FF), 0.02),
        'ffn_w_down': normal(ks[24], (DEPTH, D_FF, D_MODEL), D_FF ** -0.5),
    }


def reference(x, c, ctx, c_ctx, ada_w, ada_b, norm_pre_mix, norm_post_mix, norm_pre_ffn, norm_post_ffn,
              w_in, w_out, gdn_conv_w, gdn_a_log, gdn_dt_bias, gdn_norm, attn_q_norm, attn_k_norm,
              swa_sink, hgrn_lb_raw, hgrn_norm, ffn_w_up, ffn_conv_w, ffn_conv_b, ffn_w_down):
    rows = x.shape[1] // GRID_W
    cos, sin = axial_rope_tables(rows)
    lb_p = jax.nn.softmax(hgrn_lb_raw.astype(F32), axis=0)
    hgrn_lb = jnp.cumsum(lb_p, axis=0) - lb_p[0]
    c_act = jax.nn.silu(c)
    c_ctx_act = jax.nn.silu(c_ctx)
    x_l, x_c = x, ctx
    for layer in range(DEPTH):
        with_ctx = layer < DEPTH - 1
        mod_l = jnp.split((c_act @ ada_w[layer] + ada_b[layer])[:, None, :], N_MOD, axis=-1)
        mod_c = jnp.split(c_ctx_act @ ada_w[layer] + ada_b[layer], N_MOD, axis=-1)
        h_l = modulate(rms_norm(x_l, norm_pre_mix[layer]), mod_l[0], mod_l[1])
        h_c = modulate(rms_norm(x_c, norm_pre_mix[layer]), mod_c[0], mod_c[1])
        o_c, o_l = token_mixing(h_c, h_l, w_in[layer], w_out[layer], gdn_conv_w[layer], gdn_a_log[layer],
                                gdn_dt_bias[layer], gdn_norm[layer], attn_q_norm[layer], attn_k_norm[layer],
                                swa_sink[layer], hgrn_lb[layer], hgrn_norm[layer], cos, sin, with_ctx)
        x_l = x_l + mod_l[2] * rms_norm(o_l, norm_post_mix[layer])
        f_l = conv_ffn(modulate(rms_norm(x_l, norm_pre_ffn[layer]), mod_l[3], mod_l[4]),
                       ffn_w_up[layer], ffn_conv_w[layer], ffn_conv_b[layer], ffn_w_down[layer])
        x_l = x_l + mod_l[5] * rms_norm(f_l, norm_post_ffn[layer])
        if with_ctx:
            x_c = x_c + mod_c[2] * rms_norm(o_c, norm_post_mix[layer])
            f_c = conv_ffn(modulate(rms_norm(x_c, norm_pre_ffn[layer]), mod_c[3], mod_c[4]),
                           ffn_w_up[layer], ffn_conv_w[layer], ffn_conv_b[layer], ffn_w_down[layer])
            x_c = x_c + mod_c[5] * rms_norm(f_c, norm_post_ffn[layer])
    return x_l
```

```cpp
#include <hip/hip_runtime.h>
#include <hip/hip_cooperative_groups.h>
#include <cstdio>
#include <cstdint>
namespace cg = cooperative_groups;

typedef unsigned short bf16_t;
typedef short bf16x8 __attribute__((ext_vector_type(8)));
typedef float f32x4 __attribute__((ext_vector_type(4)));
typedef unsigned u32x4 __attribute__((ext_vector_type(4)));
#define LAS __attribute__((address_space(3)))

constexpr int D = 1024, NB = 8, SEQ = 2048, CTX = 256;
constexpr int ML = NB * SEQ, MC = NB * CTX, MT = ML + MC;
constexpr int INW = 3344, INP = 3456, FF = 2816, FF2 = 5632;
constexpr int NMOD = 6 * D;
constexpr int P_GQ = 0, P_GK = 256, P_GV = 512, P_GZ = 768, P_AQ = 1024, P_AK = 1280, P_AV = 1408, P_WQ = 1536, P_WK = 1792, P_WV = 1920,
              P_HQ = 2048, P_HF = 2304, P_HI = 2816, P_HG = 3072, P_BETA = 3328, P_A = 3336;
constexpr float EPS = 1e-6f;
constexpr int LDS_BYTES = 65536;
constexpr int VT_LD = CTX + SEQ;

struct Params {
    const float *x, *c, *ctx, *c_ctx, *ada_w, *ada_b, *n_pre_mix, *n_post_mix, *n_pre_ffn, *n_post_ffn, *w_in, *w_out, *gdn_conv_w, *gdn_a_log,
        *gdn_dt_bias, *gdn_norm, *attn_q_norm, *attn_k_norm, *swa_sink, *hgrn_lb_raw, *hgrn_norm, *ffn_w_up, *ffn_conv_w, *ffn_conv_b, *ffn_w_down;
    float* out;
    unsigned* bar;
    unsigned* ctr;
    float* mod;
    float* adapart;
    bf16_t *w_inT, *w_outT, *w_upT, *w_downT;
    float* xc;
    bf16_t* hm;
    bf16_t* p;
    bf16_t* r2;
    bf16_t* vt;
    bf16_t* gqk;
};

__device__ __forceinline__ float bf2f(bf16_t v) { return __uint_as_float(((unsigned)v) << 16); }
typedef __bf16 bf16v2 __attribute__((ext_vector_type(2)));
typedef float f32v2 __attribute__((ext_vector_type(2)));
__device__ __forceinline__ unsigned cvt_pk_bf16(float lo, float hi) { const f32v2 v = {lo, hi}; return __builtin_bit_cast(unsigned, __builtin_convertvector(v, bf16v2)); }
__device__ __forceinline__ bf16_t f2bf(float f) { return (bf16_t)(cvt_pk_bf16(f, 0.f) & 0xffffu); }
__device__ __forceinline__ float silu_f(float x) { return x * __builtin_amdgcn_rcpf(1.f + __expf(-x)); }
__device__ __forceinline__ float sigmoid_f(float x) { return __builtin_amdgcn_rcpf(1.f + __expf(-x)); }
__device__ __forceinline__ float wave_sum(float v) {
#pragma unroll
    for (int o = 32; o >= 1; o >>= 1) v += __shfl_xor(v, o);
    return v;
}
template <int CTRL> __device__ __forceinline__ float dpp_f(float x) {
    return __int_as_float(__builtin_amdgcn_update_dpp(0, __float_as_int(x), CTRL, 0xF, 0xF, true));
}
__device__ __forceinline__ float red8(float x) {
    x += dpp_f<0xB1>(x); x += dpp_f<0x4E>(x); x += dpp_f<0x141>(x); return x;
}
__device__ __forceinline__ void unpack8(u32x4 v, float* o) {
    o[0] = __uint_as_float(v[0] << 16); o[1] = __uint_as_float(v[0] & 0xffff0000u);
    o[2] = __uint_as_float(v[1] << 16); o[3] = __uint_as_float(v[1] & 0xffff0000u);
    o[4] = __uint_as_float(v[2] << 16); o[5] = __uint_as_float(v[2] & 0xffff0000u);
    o[6] = __uint_as_float(v[3] << 16); o[7] = __uint_as_float(v[3] & 0xffff0000u);
}

__device__ __forceinline__ int opaque_tid() { int t = threadIdx.x; asm volatile("" : "+v"(t)); return t; }
#define XB_TMO      128
#define XB_XCNT(j)  (256  + 64 * (j))
#define XB_XSUB(j)  (1280 + 64 * (j))
#define XB_XGEN(j)  (2304 + 64 * (j))
#define XB_TOP      3328
#define XB_TOPGEN   3392
#define XCD_BAR_WORDS 3456
#define XB_SPIN_CAP (1u << 22)
__device__ __forceinline__ unsigned xb_ld(unsigned* p)              { return __hip_atomic_load(p, __ATOMIC_RELAXED, __HIP_MEMORY_SCOPE_AGENT); }
__device__ __forceinline__ unsigned xb_add(unsigned* p, unsigned v) { return __hip_atomic_fetch_add(p, v, __ATOMIC_RELAXED, __HIP_MEMORY_SCOPE_AGENT); }
__device__ __forceinline__ unsigned xb_xcc_id() { return (unsigned)__builtin_amdgcn_s_getreg((3 << 11) | 20) & 0xFu; }
#define XB_SPIN(cond, bar) do { unsigned _sp = 0; while (cond) { __builtin_amdgcn_s_sleep(1); \
    if ((++_sp & 255u) == 0u) { if (xb_ld(&(bar)[XB_TMO])) break; if (_sp > XB_SPIN_CAP) { atomicAdd(&(bar)[XB_TMO], 1u); break; } } } } while (0)
struct XcdBarrier { unsigned* bar; unsigned x; volatile LAS unsigned* st; };
__device__ __forceinline__ XcdBarrier xcd_barrier_post(unsigned* bar, volatile LAS unsigned* st) {
    XcdBarrier b; b.bar = bar; b.x = xb_xcc_id(); b.st = st;
    if (threadIdx.x == 0) (void)xb_add(&bar[XB_XCNT(b.x)], 1u);
    return b;
}
__device__ __forceinline__ void xcd_barrier_complete(unsigned* bar, unsigned x, unsigned& nloc, unsigned& nx) {
    const unsigned G = gridDim.x * gridDim.y * gridDim.z;
    unsigned sum, cnt, mine, sp = 0u;
    for (;;) {
        sum = 0u; cnt = 0u; mine = 0u;
#pragma unroll
        for (unsigned j = 0; j < 16; ++j) { const unsigned c = xb_ld(&bar[XB_XCNT(j)]); sum += c; cnt += (c > 0u) ? 1u : 0u; mine = (j == x) ? c : mine; }
        if (sum == G) break;
        __builtin_amdgcn_s_sleep(1);
        if ((++sp & 255u) == 0u) { if (xb_ld(&bar[XB_TMO])) break; if (sp > XB_SPIN_CAP) { atomicAdd(&bar[XB_TMO], 1u); break; } }
    }
    nloc = mine > 0u ? mine : 1u; nx = cnt > 0u ? cnt : 1u;
}
__device__ __forceinline__ void xcd_barrier(const XcdBarrier& b) {
    asm volatile("s_waitcnt vmcnt(0)" ::: "memory");
    __syncthreads();
    if (threadIdx.x == 0) {
        unsigned* bar = b.bar;
        __builtin_amdgcn_s_waitcnt(0);
        unsigned nloc = b.st[0], nx = b.st[1];
        if (nloc == 0u) { xcd_barrier_complete(bar, b.x, nloc, nx); b.st[0] = nloc; b.st[1] = nx; }
        const unsigned old = xb_add(&bar[XB_XSUB(b.x)], 1u);
        const unsigned gen = old / nloc;
        if (old + 1u == (gen + 1u) * nloc) {
            __builtin_amdgcn_fence(__ATOMIC_RELEASE, "agent");
            asm volatile("s_waitcnt vmcnt(0)" ::: "memory");
            const unsigned og = xb_add(&bar[XB_TOP], 1u);
            const unsigned tg = og / nx;
            if (og + 1u == (tg + 1u) * nx) xb_add(&bar[XB_TOPGEN], 1u);
            else XB_SPIN(xb_ld(&bar[XB_TOPGEN]) == tg, bar);
            __builtin_amdgcn_fence(__ATOMIC_ACQUIRE, "agent");
            xb_add(&bar[XB_XGEN(b.x)], 1u);
            asm volatile("s_waitcnt vmcnt(0)" ::: "memory");
        } else {
            XB_SPIN(xb_ld(&bar[XB_XGEN(b.x)]) == gen, bar);
            __builtin_amdgcn_fence(__ATOMIC_ACQUIRE, "agent");
            asm volatile("s_waitcnt vmcnt(0)" ::: "memory");
        }
    }
    __syncthreads();
}

__device__ __forceinline__ void convert_tile(const float* __restrict__ W, int K, int N, bf16_t* __restrict__ Wt, int n0, int k0, int mode, float* tile) {
    const int tid = opaque_tid(), i = tid & 63, j = tid >> 6;
    const int n = n0 + i; int src = n;
    if (mode == 1) src = (n < 1024) ? n : (n < 3328 ? n + 16 : (n < 3344 ? 1024 + (n - 3328) : -1));
    else if (mode == 2) { const int blk = n >> 7, r = n & 127; src = (r < 64) ? blk * 64 + r : FF + blk * 64 + (r - 64); }
#pragma unroll 4
    for (int kk = 0; kk < 16; ++kk) { const int k = kk * 4 + j; const float v = (src >= 0) ? W[(size_t)(k0 + k) * N + src] : 0.f; tile[k * 65 + i] = v; }
    __syncthreads();
    const int nn = tid >> 2, ks = (tid & 3) * 16;
    unsigned w[8];
#pragma unroll
    for (int q = 0; q < 8; ++q) w[q] = cvt_pk_bf16(tile[(ks + 2 * q) * 65 + nn], tile[(ks + 2 * q + 1) * 65 + nn]);
    uint4* dst = (uint4*)(Wt + (size_t)(n0 + nn) * K + k0 + ks);
    dst[0] = make_uint4(w[0], w[1], w[2], w[3]); dst[1] = make_uint4(w[4], w[5], w[6], w[7]);
    __syncthreads();
}
constexpr int CONV_ITEMS = 864 + 256 + 1408 + 704;
__device__ void convert_item(const Params& P, int layer, int it, float* tile) {
    if (it < 864) { const int nt = it >> 4, kt = it & 15; convert_tile(P.w_in + (size_t)layer * D * INW, D, INW, P.w_inT, nt * 64, kt * 64, 1, tile); return; }
    it -= 864;
    if (it < 256) { const int nt = it >> 4, kt = it & 15; convert_tile(P.w_out + (size_t)layer * D * D, D, D, P.w_outT, nt * 64, kt * 64, 0, tile); return; }
    it -= 256;
    if (it < 1408) { const int nt = it >> 4, kt = it & 15; convert_tile(P.ffn_w_up + (size_t)layer * D * FF2, D, FF2, P.w_upT, nt * 64, kt * 64, 2, tile); return; }
    it -= 1408;
    { const int nt = it / 44, kt = it % 44; convert_tile(P.ffn_w_down + (size_t)layer * FF * D, FF, D, P.w_downT, nt * 64, kt * 64, 0, tile); }
}
constexpr int ADA_ITEMS = 2 * 24 * 16;
__device__ void ada_item(const Params& P, int item, float* lds) {
    const int tid = opaque_tid();
    const int kc = item & 15, cc = (item >> 4) % 24, layer = item / (16 * 24);
    for (int i = tid; i < 9 * 64; i += 256) { const int r = i >> 6, k = i & 63; const float v = (r < 8) ? P.c[r * D + kc * 64 + k] : P.c_ctx[kc * 64 + k]; lds[i] = silu_f(v); }
    __syncthreads();
    const int col = cc * 256 + tid;
    float acc[9];
#pragma unroll
    for (int r = 0; r < 9; ++r) acc[r] = 0.f;
    const float* w = P.ada_w + (size_t)layer * D * NMOD + (size_t)(kc * 64) * NMOD + col;
#pragma unroll 8
    for (int k = 0; k < 64; ++k) { const float wv = w[(size_t)k * NMOD];
#pragma unroll
        for (int r = 0; r < 9; ++r) acc[r] += lds[r * 64 + k] * wv; }
    float* part = P.adapart + (size_t)item * 9 * 256;
#pragma unroll
    for (int r = 0; r < 9; ++r) __hip_atomic_store(part + r * 256 + tid, acc[r], __ATOMIC_RELAXED, __HIP_MEMORY_SCOPE_AGENT);
    __threadfence();
    __syncthreads();
    unsigned* flag = (unsigned*)(lds + 600);
    if (tid == 0) { const unsigned old = __hip_atomic_fetch_add(P.ctr + 128 + layer * 24 + cc, 1u, __ATOMIC_ACQ_REL, __HIP_MEMORY_SCOPE_AGENT); *flag = old; }
    __syncthreads();
    const bool last = (*flag == 15u);
    if (last) {
        __threadfence();
        const float bb = P.ada_b[layer * NMOD + col];
#pragma unroll
        for (int r = 0; r < 9; ++r) { float sum = bb;
            for (int k2 = 0; k2 < 16; ++k2) sum += __hip_atomic_load(P.adapart + (size_t)((layer * 24 + cc) * 16 + k2) * 9 * 256 + r * 256 + tid, __ATOMIC_RELAXED, __HIP_MEMORY_SCOPE_AGENT);
            P.mod[(size_t)(layer * 9 + r) * NMOD + col] = sum; }
    }
    __syncthreads();
}

struct RowP { const float* xin; float* xout; const void* branch; const float *gate, *gpost, *gnext, *shift, *scale; bf16_t* hout; };
template <int BR>
__device__ __forceinline__ void rn_load(const RowP& r, f32x4 (&x)[4], f32x4 (&br)[4], int lane) {
#pragma unroll
    for (int g = 0; g < 4; ++g) x[g] = *(const f32x4*)(r.xin + g * 256 + lane * 4);
    if (BR != 0) {
#pragma unroll
        for (int g = 0; g < 4; ++g) {
            if (BR == 1) br[g] = *(const f32x4*)((const float*)r.branch + g * 256 + lane * 4);
            else { const uint2 u = *(const uint2*)((const bf16_t*)r.branch + g * 256 + lane * 4);
                   br[g] = (f32x4){__uint_as_float(u.x << 16), __uint_as_float(u.x & 0xffff0000u), __uint_as_float(u.y << 16), __uint_as_float(u.y & 0xffff0000u)}; }
        }
    }
}
template <int BR>
__device__ __forceinline__ void rn_compute(const RowP& r, f32x4 (&x)[4], f32x4 (&br)[4], int lane) {
    f32x4 gt[4], gp[4], gn[4], sh[4], sc[4];
    if (BR != 0) {
#pragma unroll
        for (int g = 0; g < 4; ++g) { gt[g] = *(const f32x4*)(r.gate + g * 256 + lane * 4); gp[g] = *(const f32x4*)(r.gpost + g * 256 + lane * 4); }
    }
    if (r.hout) {
#pragma unroll
        for (int g = 0; g < 4; ++g) { gn[g] = *(const f32x4*)(r.gnext + g * 256 + lane * 4); sh[g] = *(const f32x4*)(r.shift + g * 256 + lane * 4); sc[g] = *(const f32x4*)(r.scale + g * 256 + lane * 4); }
    }
    if (BR != 0) {
        float ss = 0.f;
#pragma unroll
        for (int g = 0; g < 4; ++g) ss += br[g][0] * br[g][0] + br[g][1] * br[g][1] + br[g][2] * br[g][2] + br[g][3] * br[g][3];
        ss = wave_sum(ss);
        const float rstd = rsqrtf(ss * (1.f / D) + EPS);
#pragma unroll
        for (int g = 0; g < 4; ++g) x[g] += gt[g] * (br[g] * rstd * gp[g]);
#pragma unroll
        for (int g = 0; g < 4; ++g) *(f32x4*)(r.xout + g * 256 + lane * 4) = x[g];
    }
    if (r.hout) {
        float ss = 0.f;
#pragma unroll
        for (int g = 0; g < 4; ++g) ss += x[g][0] * x[g][0] + x[g][1] * x[g][1] + x[g][2] * x[g][2] + x[g][3] * x[g][3];
        ss = wave_sum(ss);
        const float rstd = rsqrtf(ss * (1.f / D) + EPS);
#pragma unroll
        for (int g = 0; g < 4; ++g) { const f32x4 h = (x[g] * rstd * gn[g]) * (1.f + sc[g]) + sh[g];
            uint2 o; o.x = cvt_pk_bf16(h[0], h[1]); o.y = cvt_pk_bf16(h[2], h[3]);
            *(uint2*)(r.hout + g * 256 + lane * 4) = o; }
    }
}
template <int KIND>
__device__ __forceinline__ RowP rn_setup(const Params& P, int layer, int row) {
    const bool lat = row < ML;
    const int cond = lat ? (row >> 11) : 8;
    const float* modl = P.mod + (size_t)(layer * 9 + cond) * NMOD;
    bf16_t* h = P.hm + (size_t)row * D;
    RowP r{};
    if (KIND == 0) {
        r.xin = lat ? P.x + (size_t)row * D : P.ctx + (size_t)(row - ML) * D;
        r.gnext = P.n_pre_mix + layer * D; r.shift = modl; r.scale = modl + D; r.hout = h;
    } else if (KIND == 1) {
        r.xin = (layer == 0) ? (lat ? P.x + (size_t)row * D : P.ctx + (size_t)(row - ML) * D) : (lat ? P.out + (size_t)row * D : P.xc + (size_t)(row - ML) * D);
        r.xout = lat ? P.out + (size_t)row * D : P.xc + (size_t)(row - ML) * D;
        r.branch = (const float*)P.p + (size_t)row * D; r.gate = modl + 2 * D; r.gpost = P.n_post_mix + layer * D;
        r.gnext = P.n_pre_ffn + layer * D; r.shift = modl + 3 * D; r.scale = modl + 4 * D; r.hout = h;
    } else {
        float* xo = lat ? P.out + (size_t)row * D : P.xc + (size_t)(row - ML) * D;
        const bool nxt = layer == 0;
        const float* modn = P.mod + (size_t)((layer + 1) * 9 + cond) * NMOD;
        r.xin = xo; r.xout = xo; r.branch = P.r2 + (size_t)row * D; r.gate = modl + 5 * D; r.gpost = P.n_post_ffn + layer * D;
        if (nxt) { r.gnext = P.n_pre_mix + (layer + 1) * D; r.shift = modn; r.scale = modn + D; r.hout = h; }
    }
    return r;
}
template <int KIND>
__device__ __forceinline__ void resnorm_loop(const Params& P, int layer, int nrows) {
    constexpr int BR = KIND;
    const int tid_ = opaque_tid(); const int wid = tid_ >> 6, lane = tid_ & 63;
    const int stride = gridDim.x * 4;
    int row = blockIdx.x * 4 + wid;
    if (row >= nrows) return;
    f32x4 x[4], br[4];
    RowP cur = rn_setup<KIND>(P, layer, row);
    rn_load<BR>(cur, x, br, lane);
    for (;;) {
        const int nrow = row + stride;
        f32x4 xn[4], bn[4]; RowP nxt{};
        const bool more = nrow < nrows;
        if (more) { nxt = rn_setup<KIND>(P, layer, nrow); rn_load<BR>(nxt, xn, bn, lane); }
        rn_compute<BR>(cur, x, br, lane);
        if (!more) break;
#pragma unroll
        for (int g = 0; g < 4; ++g) { x[g] = xn[g]; br[g] = bn[g]; }
        cur = nxt; row = nrow;
    }
}
__device__ void resnorm_phase(const Params& P, int layer, int kind, int nrows) {
    if (kind == 0) resnorm_loop<0>(P, layer, nrows); else if (kind == 1) resnorm_loop<1>(P, layer, nrows); else resnorm_loop<2>(P, layer, nrows);
}

enum { EPI_P = 0, EPI_F32 = 1, EPI_BF16 = 2, EPI_FFNUP = 3 };
struct EpiArgs { void* out; int ldc; int ncols; const float* cw; const float* cb; int seq_lo, seq_hi, out_lo, out_hi, nblk; };
template <int EPI>
__device__ __forceinline__ void gemm_tile(const bf16_t* __restrict__ A, int lda, int arow_base, int arow_lo, int arow_hi, const bf16_t* __restrict__ Bt, int K, int n0,
                                          const EpiArgs& E, char* lds) {
    const int tid = opaque_tid(), wid = __builtin_amdgcn_readfirstlane(tid >> 6), lane = tid & 63, wm = wid >> 1, wn = wid & 1, lr = lane & 15, quad = lane >> 4;
    const int sr = tid >> 3, sc = (tid & 7) ^ (sr & 7);
    const bf16_t* ap[4]; const bf16_t* bp[4];
#pragma unroll
    for (int i = 0; i < 4; ++i) { int r = arow_base + sr + 32 * i; r = r < arow_lo ? arow_lo : (r >= arow_hi ? arow_hi - 1 : r);
        ap[i] = A + (size_t)r * lda + sc * 8; bp[i] = Bt + (size_t)(n0 + sr + 32 * i) * K + sc * 8; }
    LAS char* l3 = (LAS char*)lds;
    auto stage = [&](int kt, int buf) {
#pragma unroll
        for (int i = 0; i < 4; ++i) {
            __builtin_amdgcn_global_load_lds((const unsigned*)(ap[i] + kt * 64), (LAS unsigned*)(l3 + buf * 32768 + i * 4096 + wid * 1024), 16, 0, 0);
            __builtin_amdgcn_global_load_lds((const unsigned*)(bp[i] + kt * 64), (LAS unsigned*)(l3 + buf * 32768 + 16384 + i * 4096 + wid * 1024), 16, 0, 0);
        }
    };
    f32x4 acc[4][4];
#pragma unroll
    for (int mi = 0; mi < 4; ++mi)
#pragma unroll
        for (int ni = 0; ni < 4; ++ni) acc[mi][ni] = (f32x4){0.f, 0.f, 0.f, 0.f};
    const int nk = K >> 6;
    __syncthreads();
    stage(0, 0);
    for (int kt = 0; kt < nk; ++kt) {
        asm volatile("s_waitcnt vmcnt(0)" ::: "memory");
        __syncthreads();
        if (kt + 1 < nk) stage(kt + 1, (kt + 1) & 1);
        const char* As = lds + (kt & 1) * 32768; const char* Bs = As + 16384;
#pragma unroll
        for (int ks = 0; ks < 2; ++ks) {
            bf16x8 af[4], bfr[4];
            const int ch = ks * 4 + quad;
#pragma unroll
            for (int mi = 0; mi < 4; ++mi) { const int r = wm * 64 + mi * 16 + lr; af[mi] = *(const bf16x8*)(As + r * 128 + ((ch ^ (r & 7)) * 16)); }
#pragma unroll
            for (int ni = 0; ni < 4; ++ni) { const int r = wn * 64 + ni * 16 + lr; bfr[ni] = *(const bf16x8*)(Bs + r * 128 + ((ch ^ (r & 7)) * 16)); }
            __builtin_amdgcn_s_setprio(1);
#pragma unroll
            for (int mi = 0; mi < 4; ++mi)
#pragma unroll
                for (int ni = 0; ni < 4; ++ni) acc[mi][ni] = __builtin_amdgcn_mfma_f32_16x16x32_bf16(bfr[ni], af[mi], acc[mi][ni], 0, 0, 0);
            __builtin_amdgcn_s_setprio(0);
        }
    }
#ifdef EXP_A
    if (EPI == EPI_FFNUP) {
#pragma unroll
        for (int mi = 0; mi < 4; ++mi) { const int i = wm * 64 + mi * 16 + lr; const int grow = arow_base + i;
#pragma unroll
            for (int ni = 0; ni < 4; ++ni) if (wn == 0 && i >= 1 && i <= 126 && grow < E.out_hi) { uint2 o; o.x = cvt_pk_bf16(acc[mi][ni][0], acc[mi][ni][1]); o.y = cvt_pk_bf16(acc[mi][ni][2], acc[mi][ni][3]);
                *(uint2*)((bf16_t*)E.out + (size_t)grow * FF + E.nblk * 64 + ni * 16 + quad * 4) = o; } }
    } else
#endif
    if (EPI == EPI_FFNUP) {
        __syncthreads();
        bf16_t* U = (bf16_t*)lds;
#pragma unroll
        for (int mi = 0; mi < 4; ++mi)
#pragma unroll
            for (int ni = 0; ni < 4; ++ni) { uint2 o; o.x = cvt_pk_bf16(acc[mi][ni][0], acc[mi][ni][1]); o.y = cvt_pk_bf16(acc[mi][ni][2], acc[mi][ni][3]);
                *(uint2*)(U + (wm * 64 + mi * 16 + lr) * 136 + wn * 64 + ni * 16 + quad * 4) = o; }
        __syncthreads();
        auto ld4 = [&](int r, int c) { const uint2 u = *(const uint2*)(U + r * 136 + c);
            return (f32x4){__uint_as_float(u.x << 16), __uint_as_float(u.x & 0xffff0000u), __uint_as_float(u.y << 16), __uint_as_float(u.y & 0xffff0000u)}; };
        const int j4 = (tid & 15) * 4; const int f0 = E.nblk * 64 + j4;
        f32x4 wg[3], wv[3];
#pragma unroll
        for (int kk = 0; kk < 3; ++kk) { wg[kk] = *(const f32x4*)(E.cw + kk * FF2 + f0); wv[kk] = *(const f32x4*)(E.cw + kk * FF2 + FF + f0); }
        const f32x4 bg = *(const f32x4*)(E.cb + f0), bv = *(const f32x4*)(E.cb + FF + f0);
#pragma unroll
        for (int rr = 0; rr < 8; ++rr) {
            const int i = (tid >> 4) + 16 * rr; const int grow = arow_base + i;
            if (i >= 1 && i <= 126 && grow >= E.out_lo && grow < E.out_hi) {
                const float mp = (grow - 1 >= E.seq_lo) ? 1.f : 0.f, mn = (grow + 1 < E.seq_hi) ? 1.f : 0.f;
                const f32x4 gp = ld4(i - 1, j4), gc = ld4(i, j4), gn = ld4(i + 1, j4);
                const f32x4 vp = ld4(i - 1, 64 + j4), vc = ld4(i, 64 + j4), vn = ld4(i + 1, 64 + j4);
                const f32x4 cg_ = wg[0] * gp * mp + wg[1] * gc + wg[2] * gn * mn + bg;
                const f32x4 cv_ = wv[0] * vp * mp + wv[1] * vc + wv[2] * vn * mn + bv;
                uint2 o; o.x = cvt_pk_bf16(silu_f(cg_[0]) * cv_[0], silu_f(cg_[1]) * cv_[1]); o.y = cvt_pk_bf16(silu_f(cg_[2]) * cv_[2], silu_f(cg_[3]) * cv_[3]);
                *(uint2*)((bf16_t*)E.out + (size_t)grow * FF + f0) = o;
            }
        }
    } else {
#pragma unroll
        for (int mi = 0; mi < 4; ++mi) {
            const int row = arow_base + wm * 64 + mi * 16 + lr;
#pragma unroll
            for (int ni = 0; ni < 4; ++ni) {
                const int col = n0 + wn * 64 + ni * 16 + quad * 4;
                if (EPI == EPI_F32) *(f32x4*)((float*)E.out + (size_t)row * E.ldc + col) = acc[mi][ni];
                else if (col < E.ncols) { uint2 o; o.x = cvt_pk_bf16(acc[mi][ni][0], acc[mi][ni][1]); o.y = cvt_pk_bf16(acc[mi][ni][2], acc[mi][ni][3]);
                    *(uint2*)((bf16_t*)E.out + (size_t)row * E.ldc + col) = o; }
            }
        }
    }
}
template <int EPI>
__device__ void gemm_phase(const bf16_t* A, int lda, int M, const bf16_t* Bt, int K, int ntn, void* out, int ldc, int ncols, char* lds) {
    const int ntm = M / 128, nt = ntm * ntn;
    EpiArgs E{}; E.out = out; E.ldc = ldc; E.ncols = ncols;
    if ((ntm & 7) == 0 && (gridDim.x & 7) == 0) {
        const int xcd = blockIdx.x & 7, lb = blockIdx.x >> 3, nlb = gridDim.x >> 3, per = (ntm >> 3) * ntn;
        const int mloc = ntm >> 3, nig = 8 * ntn;
        for (int q = lb; q < per; q += nlb) { const int gid = q / nig, fm = gid * 8, gsz = min(mloc - fm, 8), rr = q % nig; const int tm = (fm + rr % gsz) * 8 + xcd, tn = rr / gsz;
            gemm_tile<EPI>(A, lda, tm * 128, 0, M, Bt, K, tn * 128, E, lds); }
        return;
    }
    for (int t = blockIdx.x; t < nt; t += gridDim.x) {
        const int tm = t / ntn, tn = t % ntn;
        gemm_tile<EPI>(A, lda, tm * 128, 0, M, Bt, K, tn * 128, E, lds);
    }
}

__device__ __forceinline__ int swz4(int r) { return (0x78 >> (((r >> 2) & 3) * 2)) & 3; }
__device__ __forceinline__ void ffnup_tile256(const bf16_t* __restrict__ A, int arow_base, int arow_lo, int arow_hi, const bf16_t* __restrict__ Bt, int n0, const EpiArgs& E, int tn, char* lds) {
    const int tid = opaque_tid(), wid = __builtin_amdgcn_readfirstlane(tid >> 6), lane = tid & 63, wm = wid >> 1, wn = wid & 1, lr = lane & 15, quad = lane >> 4;
    constexpr int K = D, STG = 24576;
    unsigned aofs[2], bofs[4];
#pragma unroll
    for (int i = 0; i < 2; ++i) { const int rl = (i * 4 + wid) * 16 + (lane >> 2); const int c = (lane & 3) ^ swz4(rl);
        int r = arow_base + rl; r = r < arow_lo ? arow_lo : (r >= arow_hi ? arow_hi - 1 : r);
        aofs[i] = (unsigned)r * K + c * 8; }
#pragma unroll
    for (int i = 0; i < 4; ++i) { const int rl = (i * 4 + wid) * 16 + (lane >> 2); const int c = (lane & 3) ^ swz4(rl);
        bofs[i] = (unsigned)(n0 + rl) * K + c * 8; }
    LAS char* l3 = (LAS char*)lds;
    auto stage = [&](int kt, int buf) {
#pragma unroll
        for (int i = 0; i < 2; ++i) __builtin_amdgcn_global_load_lds((const unsigned*)(A + aofs[i] + kt * 32), (LAS unsigned*)(l3 + buf * STG + (i * 4 + wid) * 1024), 16, 0, 0);
#pragma unroll
        for (int i = 0; i < 4; ++i) __builtin_amdgcn_global_load_lds((const unsigned*)(Bt + bofs[i] + kt * 32), (LAS unsigned*)(l3 + buf * STG + 8192 + (i * 4 + wid) * 1024), 16, 0, 0);
    };
    f32x4 acc[4][8];
#pragma unroll
    for (int mi = 0; mi < 4; ++mi)
#pragma unroll
        for (int ni = 0; ni < 8; ++ni) acc[mi][ni] = (f32x4){0.f, 0.f, 0.f, 0.f};
    const int ra = wm * 64 + lr, rb = wn * 128 + lr;
    const int aoff0 = ra * 64 + ((quad ^ swz4(ra)) * 16), boff0 = 8192 + rb * 64 + ((quad ^ swz4(rb)) * 16);
    constexpr int nk = K >> 5;
    __syncthreads();
    stage(0, 0);
    for (int kt = 0; kt < nk; ++kt) {
        asm volatile("s_waitcnt vmcnt(0)" ::: "memory");
        __syncthreads();
        if (kt + 1 < nk) stage(kt + 1, (kt + 1) & 1);
        const char* Sb = lds + (kt & 1) * STG;
        bf16x8 af[4];
#pragma unroll
        for (int mi = 0; mi < 4; ++mi) af[mi] = *(const bf16x8*)(Sb + aoff0 + mi * 1024);
        __builtin_amdgcn_s_setprio(1);
#pragma unroll
        for (int nh = 0; nh < 2; ++nh) {
            bf16x8 bfr[4];
#pragma unroll
            for (int q = 0; q < 4; ++q) bfr[q] = *(const bf16x8*)(Sb + boff0 + (nh * 4 + q) * 1024);
#pragma unroll
            for (int mi = 0; mi < 4; ++mi)
#pragma unroll
                for (int q = 0; q < 4; ++q) acc[mi][nh * 4 + q] = __builtin_amdgcn_mfma_f32_16x16x32_bf16(bfr[q], af[mi], acc[mi][nh * 4 + q], 0, 0, 0);
        }
        __builtin_amdgcn_s_setprio(0);
    }
    bf16_t* U = (bf16_t*)lds;
    auto ld4 = [&](int r, int c) { const uint2 u = *(const uint2*)(U + r * 136 + c);
        return (f32x4){__uint_as_float(u.x << 16), __uint_as_float(u.x & 0xffff0000u), __uint_as_float(u.y << 16), __uint_as_float(u.y & 0xffff0000u)}; };
#pragma unroll
    for (int h = 0; h < 2; ++h) {
        const int j4 = (tid & 15) * 4; const int f0 = (2 * tn + h) * 64 + j4;
        f32x4 wg[3], wv[3];
#pragma unroll
        for (int kk = 0; kk < 3; ++kk) { wg[kk] = *(const f32x4*)(E.cw + kk * FF2 + f0); wv[kk] = *(const f32x4*)(E.cw + kk * FF2 + FF + f0); }
        const f32x4 bg = *(const f32x4*)(E.cb + f0), bv = *(const f32x4*)(E.cb + FF + f0);
        __syncthreads();
        if (wn == h) {
#pragma unroll
            for (int mi = 0; mi < 4; ++mi)
#pragma unroll
                for (int ni = 0; ni < 8; ++ni) { uint2 o; o.x = cvt_pk_bf16(acc[mi][ni][0], acc[mi][ni][1]); o.y = cvt_pk_bf16(acc[mi][ni][2], acc[mi][ni][3]);
                    *(uint2*)(U + (wm * 64 + mi * 16 + lr) * 136 + ni * 16 + quad * 4) = o; }
        }
        __syncthreads();
#pragma unroll
        for (int rr = 0; rr < 8; ++rr) {
            const int i = (tid >> 4) + 16 * rr; const int grow = arow_base + i;
            if (i >= 1 && i <= 126 && grow >= E.out_lo && grow < E.out_hi) {
                const float mp = (grow - 1 >= E.seq_lo) ? 1.f : 0.f, mn = (grow + 1 < E.seq_hi) ? 1.f : 0.f;
                const f32x4 gp = ld4(i - 1, j4), gc = ld4(i, j4), gn = ld4(i + 1, j4);
                const f32x4 vp = ld4(i - 1, 64 + j4), vc = ld4(i, 64 + j4), vn = ld4(i + 1, 64 + j4);
                const f32x4 cg_ = wg[0] * gp * mp + wg[1] * gc + wg[2] * gn * mn + bg;
                const f32x4 cv_ = wv[0] * vp * mp + wv[1] * vc + wv[2] * vn * mn + bv;
                uint2 o; o.x = cvt_pk_bf16(silu_f(cg_[0]) * cv_[0], silu_f(cg_[1]) * cv_[1]); o.y = cvt_pk_bf16(silu_f(cg_[2]) * cv_[2], silu_f(cg_[3]) * cv_[3]);
                *(uint2*)((bf16_t*)E.out + (size_t)grow * FF + f0) = o;
            }
        }
    }
}

__device__ void ffnup_phase(const Params& P, int layer, bool with_ctx, char* lds) {
    const int ntn = FF2 / 256;
    const int ntm = 8 * 17 + (with_ctx ? 8 * 3 : 0);
    const int nt = ntm * ntn;
    EpiArgs E{}; E.out = P.p; E.cw = P.ffn_conv_w + (size_t)layer * 3 * FF2; E.cb = P.ffn_conv_b + (size_t)layer * FF2;
    const bool xcdord = ((ntm & 7) == 0) && ((gridDim.x & 7) == 0);
    const int xcd = blockIdx.x & 7, lb = blockIdx.x >> 3, nlb = gridDim.x >> 3, per = (ntm >> 3) * ntn;
    for (int t = xcdord ? lb : blockIdx.x; t < (xcdord ? per : nt); t += (xcdord ? nlb : gridDim.x)) {
        int tm, tn;
        if (xcdord) { const int mloc = ntm >> 3, nig = 8 * ntn, gid = t / nig, fm = gid * 8, gsz = min(mloc - fm, 8), rr = t % nig; tm = (fm + rr % gsz) * 8 + xcd; tn = rr / gsz; }
        else { tm = t / ntn; tn = t % ntn; }
        int s0, L, j;
        if (tm < 136) { s0 = (tm / 17) * SEQ; L = SEQ; j = tm % 17; } else { const int q = tm - 136; s0 = ML + (q / 3) * CTX; L = CTX; j = q % 3; }
        E.seq_lo = s0; E.seq_hi = s0 + L; E.out_lo = s0 + 126 * j; E.out_hi = min(s0 + 126 * j + 126, s0 + L); E.nblk = tn;
        ffnup_tile256(P.hm, s0 + 126 * j - 1, s0, s0 + L, P.w_upT, tn * 256, E, tn, lds);
    }
}

constexpr int VT_ITEMS = 2 * 8 * 2 * 36;
__device__ void vt_item(const Params& P, int it, char* lds) {
    const int tid = opaque_tid();
    const int pt = it % 36, kvh = (it / 36) & 1, b = (it / 72) & 7, type = it / 576;
    const int row0 = (pt < 4) ? (ML + b * CTX + pt * 64) : (b * SEQ + (pt - 4) * 64);
    const int vcol = (type ? P_WV : P_AV) + kvh * 64;
    bf16_t* T = (bf16_t*)lds;
    { const int pos = tid >> 2, seg = (tid & 3) * 16;
      const uint4* src = (const uint4*)(P.p + (size_t)(row0 + pos) * INW + vcol + seg);
      const uint4 a = src[0], c = src[1];
      *(uint4*)(T + pos * 72 + seg) = a; *(uint4*)(T + pos * 72 + seg + 8) = c; }
    __syncthreads();
    { const int dim = tid >> 2, ps = (tid & 3) * 16;
      unsigned w[8];
#pragma unroll
      for (int q = 0; q < 8; ++q) w[q] = (unsigned)T[(ps + 2 * q) * 72 + dim] | ((unsigned)T[(ps + 2 * q + 1) * 72 + dim] << 16);
      uint4* dst = (uint4*)(P.vt + ((size_t)((type * 8 + b) * 2 + kvh) * 64 + dim) * VT_LD + pt * 64 + ps);
      dst[0] = make_uint4(w[0], w[1], w[2], w[3]); dst[1] = make_uint4(w[4], w[5], w[6], w[7]); }
    __syncthreads();
}
__device__ void qkprep_rows(const Params& P, int layer, int row, int lane) {
    const bool lat = row < ML;
    const int t = lat ? (row & (SEQ - 1)) : 0;
    const int i = lane & 31;
    float cs = 1.f, sn = 0.f;
    if (lat) { const int fi = i & 15; const float invf = exp2f(-(float)fi * (13.287712379549449f / 16.f)); const float pos = (i < 16) ? (float)(t >> 6) : (float)(t & 63);
        const float ang = pos * invf; cs = __cosf(ang); sn = __sinf(ang); }
    bf16_t* pr = P.p + (size_t)row * INW;
    const float qs = 0.125f * 1.4426950408889634f;
#pragma unroll
    for (int it = 0; it < 6; ++it) {
        const int slot = it * 2 + (lane >> 5);
        int col; float scl = 1.f; const float* gain = nullptr;
        if (slot < 4) { col = P_AQ + slot * 64; gain = P.attn_q_norm + layer * 64; scl = qs; }
        else if (slot < 6) { col = P_AK + (slot - 4) * 64; gain = P.attn_k_norm + layer * 64; }
        else if (slot < 10) { col = P_WQ + (slot - 6) * 64; scl = qs; }
        else col = P_WK + (slot - 10) * 64;
        unsigned* ptr = (unsigned*)(pr + col + 2 * i);
        const unsigned u = *ptr;
        float x0 = __uint_as_float(u << 16), x1 = __uint_as_float(u & 0xffff0000u);
        if (slot < 6) {
            float ss = x0 * x0 + x1 * x1;
#pragma unroll
            for (int o = 16; o >= 1; o >>= 1) ss += __shfl_xor(ss, o);
            const float rstd = rsqrtf(ss * (1.f / 64.f) + EPS);
            x0 = x0 * rstd * gain[2 * i]; x1 = x1 * rstd * gain[2 * i + 1];
        }
        const float y0 = (x0 * cs - x1 * sn) * scl, y1 = (x0 * sn + x1 * cs) * scl;
        *ptr = cvt_pk_bf16(y0, y1);
    }
}


__device__ __forceinline__ void gdnprep_row(const Params& P, int layer, int row, int lane, const float (&cwr)[24]) {
    const bool lat = row < ML; const int s0 = lat ? (row & ~(SEQ - 1)) : (ML + ((row - ML) & ~(CTX - 1))), L = lat ? SEQ : CTX, t = row - s0;
    const int seg = lane >> 5, c0 = (lane & 31) * 8, pcol = (seg ? P_GK : P_GQ) + c0;
    float x0[8], x1[8], x2[8];
    const u32x4 z4 = {0u, 0u, 0u, 0u};
    unpack8(t > 0 ? *(const u32x4*)(P.p + (size_t)(row - 1) * INW + pcol) : z4, x0);
    unpack8(*(const u32x4*)(P.p + (size_t)row * INW + pcol), x1);
    unpack8(t + 1 < L ? *(const u32x4*)(P.p + (size_t)(row + 1) * INW + pcol) : z4, x2);
    float y[8], ss = 0.f;
#pragma unroll
    for (int q = 0; q < 8; ++q) { const float v = silu_f(cwr[q] * x0[q] + cwr[8 + q] * x1[q] + cwr[16 + q] * x2[q]); y[q] = v; ss += v * v; }
    ss = red8(ss);
    const float sc = rsqrtf(ss + EPS) * (seg == 0 ? 0.125f : 1.f);
    const u32x4 pk = {cvt_pk_bf16(y[0] * sc, y[1] * sc), cvt_pk_bf16(y[2] * sc, y[3] * sc), cvt_pk_bf16(y[4] * sc, y[5] * sc), cvt_pk_bf16(y[6] * sc, y[7] * sc)};
    *(u32x4*)(P.gqk + (size_t)row * 512 + lane * 8) = pk;
}

__device__ void attn_item(const Params& P, int layer, int type, int b, int kvh, int qt, bool is_ctx, char* lds) {
    const int tid = opaque_tid(), w = tid >> 6, lane = tid & 63, lr = lane & 15, quad = lane >> 4;
    const bf16_t* pp = P.p;
    const int qcol = (type ? P_WQ : P_AQ) + kvh * 128, kcol = (type ? P_WK : P_AK) + kvh * 64;
    const int qrow0 = is_ctx ? (ML + b * CTX + qt * 64) : (b * SEQ + qt * 64);
    const int myq = qrow0 + w * 16 + lr;
    bf16x8 qf[2][2];
#pragma unroll
    for (int g = 0; g < 2; ++g)
#pragma unroll
        for (int ks = 0; ks < 2; ++ks) qf[g][ks] = *(const bf16x8*)(pp + (size_t)myq * INW + qcol + g * 64 + ks * 32 + quad * 8);
    int lt0 = 0, nlat = 0;
    if (!is_ctx) { if (type == 0) { lt0 = 0; nlat = 32; } else { lt0 = max(0, qt - 2); nlat = min(31, qt + 2) - lt0 + 1; } }
    const int nt = 4 + nlat;
    const bf16_t* vbase = P.vt + (size_t)((type * 8 + b) * 2 + kvh) * 64 * VT_LD;
    char* Ks = lds; char* Vs = lds + 8192;
    const int sr = tid >> 3, sc = tid & 7;
    const int swr = sr * 128 + ((sc ^ (sr & 7)) * 16);
    float m[2], l[2]; f32x4 o[2][4];
#pragma unroll
    for (int g = 0; g < 2; ++g) {
        if (type == 1) { m[g] = P.swa_sink[layer * 4 + kvh * 2 + g] * 1.4426950408889634f; l[g] = (quad == 0) ? 1.f : 0.f; } else { m[g] = -1e30f; l[g] = 0.f; }
#pragma unroll
        for (int db = 0; db < 4; ++db) o[g][db] = (f32x4){0.f, 0.f, 0.f, 0.f};
    }
    u32x4 rk[2], rv[2];
    auto issue = [&](int ti) {
        const int krow0 = (ti < 4) ? (ML + b * CTX + ti * 64) : (b * SEQ + (lt0 + ti - 4) * 64);
        const int pos0 = (ti < 4) ? ti * 64 : 256 + (lt0 + ti - 4) * 64;
#pragma unroll
        for (int i = 0; i < 2; ++i) { rk[i] = *(const u32x4*)(pp + (size_t)(krow0 + sr + 32 * i) * INW + kcol + sc * 8);
            rv[i] = *(const u32x4*)(vbase + (size_t)(sr + 32 * i) * VT_LD + pos0 + sc * 8); }
    };
    issue(0);
    const int qp = qt * 64 + w * 16 + lr;
    for (int ti = 0; ti < nt; ++ti) {
        __syncthreads();
#pragma unroll
        for (int i = 0; i < 2; ++i) { *(u32x4*)(Ks + swr + i * 4096) = rk[i]; *(u32x4*)(Vs + swr + i * 4096) = rv[i]; }
        __syncthreads();
        if (ti + 1 < nt) issue(ti + 1);
        f32x4 s[2][4];
#pragma unroll
        for (int g = 0; g < 2; ++g)
#pragma unroll
            for (int kb = 0; kb < 4; ++kb) s[g][kb] = (f32x4){0.f, 0.f, 0.f, 0.f};
#pragma unroll
        for (int ks = 0; ks < 2; ++ks)
#pragma unroll
            for (int kb = 0; kb < 4; ++kb) { const int r = kb * 16 + lr; const int ch = ks * 4 + quad;
                const bf16x8 kf = *(const bf16x8*)(Ks + r * 128 + ((ch ^ (r & 7)) * 16));
#pragma unroll
                for (int g = 0; g < 2; ++g) s[g][kb] = __builtin_amdgcn_mfma_f32_16x16x32_bf16(kf, qf[g][ks], s[g][kb], 0, 0, 0); }
        if (type == 1 && ti >= 4) {
            const int kp0 = (lt0 + ti - 4) * 64 + quad * 4;
#pragma unroll
            for (int kb = 0; kb < 4; ++kb)
#pragma unroll
                for (int j = 0; j < 4; ++j) { const int dlt = qp - (kp0 + kb * 16 + j); const bool ok = (dlt <= 128) && (dlt >= -128);
#pragma unroll
                    for (int g = 0; g < 2; ++g) s[g][kb][j] = ok ? s[g][kb][j] : -1e30f; }
        }
        bf16x8 pf[2][2];
#pragma unroll
        for (int g = 0; g < 2; ++g) {
            float mx = -1e30f;
#pragma unroll
            for (int kb = 0; kb < 4; ++kb) mx = fmaxf(mx, fmaxf(fmaxf(s[g][kb][0], s[g][kb][1]), fmaxf(s[g][kb][2], s[g][kb][3])));
            mx = fmaxf(mx, __shfl_xor(mx, 16)); mx = fmaxf(mx, __shfl_xor(mx, 32));
            const float mn = fmaxf(m[g], mx); const float alpha = __builtin_amdgcn_exp2f(m[g] - mn); m[g] = mn;
            float ps = 0.f;
#pragma unroll
            for (int kb = 0; kb < 4; ++kb)
#pragma unroll
                for (int j = 0; j < 4; ++j) { const float e = __builtin_amdgcn_exp2f(s[g][kb][j] - mn); s[g][kb][j] = e; ps += e; }
            l[g] = l[g] * alpha + ps;
#pragma unroll
            for (int db = 0; db < 4; ++db) o[g][db] *= alpha;
#pragma unroll
            for (int ks = 0; ks < 2; ++ks) {
                u32x4 pk;
                pk[0] = cvt_pk_bf16(s[g][2 * ks][0], s[g][2 * ks][1]); pk[1] = cvt_pk_bf16(s[g][2 * ks][2], s[g][2 * ks][3]);
                pk[2] = cvt_pk_bf16(s[g][2 * ks + 1][0], s[g][2 * ks + 1][1]); pk[3] = cvt_pk_bf16(s[g][2 * ks + 1][2], s[g][2 * ks + 1][3]);
                pf[g][ks] = __builtin_bit_cast(bf16x8, pk);
            }
        }
#pragma unroll
        for (int ks = 0; ks < 2; ++ks)
#pragma unroll
            for (int db = 0; db < 4; ++db) { const int dim = db * 16 + lr; const int c1 = ks * 4 + (quad >> 1), c2 = c1 + 2;
                const uint2 h0 = *(const uint2*)(Vs + dim * 128 + ((c1 ^ (dim & 7)) * 16) + (quad & 1) * 8);
                const uint2 h1 = *(const uint2*)(Vs + dim * 128 + ((c2 ^ (dim & 7)) * 16) + (quad & 1) * 8);
                const bf16x8 vfv = __builtin_bit_cast(bf16x8, (u32x4){h0.x, h0.y, h1.x, h1.y});
#pragma unroll
                for (int g = 0; g < 2; ++g) o[g][db] = __builtin_amdgcn_mfma_f32_16x16x32_bf16(vfv, pf[g][ks], o[g][db], 0, 0, 0); }
    }
    const int mixcol = (type ? 512 : 256) + kvh * 128;
#pragma unroll
    for (int g = 0; g < 2; ++g) {
        float lt = l[g]; lt += __shfl_xor(lt, 16); lt += __shfl_xor(lt, 32);
        const float inv = 1.f / lt;
#pragma unroll
        for (int db = 0; db < 4; ++db) { uint2 ov; ov.x = cvt_pk_bf16(o[g][db][0] * inv, o[g][db][1] * inv); ov.y = cvt_pk_bf16(o[g][db][2] * inv, o[g][db][3] * inv);
            *(uint2*)(P.hm + (size_t)myq * D + mixcol + g * 64 + db * 16 + quad * 4) = ov; }
    }
    __syncthreads();
}

constexpr int TCH = 32;

typedef short bf16x4 __attribute__((ext_vector_type(4)));
typedef unsigned u32x2 __attribute__((ext_vector_type(2)));
__device__ __forceinline__ bf16x4 pack4(f32x4 v) { const u32x2 u = {cvt_pk_bf16(v[0], v[1]), cvt_pk_bf16(v[2], v[3])}; return __builtin_bit_cast(bf16x4, u); }
__device__ __forceinline__ f32x4 unpack4(u32x2 u) { return (f32x4){__uint_as_float(u[0] << 16), __uint_as_float(u[0] & 0xffff0000u), __uint_as_float(u[1] << 16), __uint_as_float(u[1] & 0xffff0000u)}; }
__device__ void gdn_chunked(const Params& P, int layer, int item, char* lds) {
    __builtin_amdgcn_s_setprio(3);
    const int tid0 = opaque_tid(), w = __builtin_amdgcn_readfirstlane(tid0 >> 6);
    const int dir = item & 1, h = (item >> 1) & 3, b = item >> 3;
    constexpr int TSE = 64 * 72;
    bf16_t* St = (bf16_t*)lds;
    bf16_t* Kh = St + TSE;
    bf16_t* Qh = Kh + TSE;
    bf16_t* Vt = Qh + TSE;
    bf16_t* Kdt = Vt + TSE;
    bf16_t* nM = Kdt + TSE;
    bf16_t* At = nM + TSE;
    bf16_t* raw = nM;
    float* cw = (float*)(lds + 59136);
    float* gsc = (float*)(lds + 64512);
    const float neg_ea = -__expf(P.gdn_a_log[layer * 8 + dir * 4 + h]);
    const float dtb = P.gdn_dt_bias[layer * 8 + dir * 4 + h];
    f32x4 Sreg[4];
#pragma unroll
    for (int nb = 0; nb < 4; ++nb) Sreg[nb] = (f32x4){0.f, 0.f, 0.f, 0.f};
    for (int i = tid0; i < TSE / 2; i += 256) ((unsigned*)St)[i] = 0u;
    u32x4 preqk[4], prev[3]; unsigned pab = 0;
    int tid = tid0;
    const float cwreg = (tid0 < 192) ? P.gdn_conv_w[(size_t)layer * 3 * 768 + (tid0 >> 6) * 768 + 512 + h * 64 + (tid0 & 63)] : 0.f;
    bf16_t* rawv = nM;
    float* cwv = (float*)(lds + 59136);
    auto chunk_info = [&](int ci, int& sbase, int& L, int& t0c, bool& isctx) {
        isctx = ci < 4; const int n = isctx ? 4 : 32; int cj = isctx ? ci : ci - 4; if (dir) cj = n - 1 - cj;
        sbase = isctx ? (ML + b * CTX) : (b * SEQ); L = isctx ? CTX : SEQ; t0c = cj * 64;
    };
    auto issue = [&](int ci) {
        int sbase, L, t0c; bool isctx; chunk_info(ci, sbase, L, t0c, isctx);
#pragma unroll
        for (int i = 0; i < 4; ++i) { const int idx = tid + 256 * i; const int row = idx >> 4, part = idx & 15; const int trow = t0c + (dir ? 63 - row : row);
            const int col = (part < 8) ? h * 64 + part * 8 : 256 + h * 64 + (part - 8) * 8;
            preqk[i] = *(const u32x4*)(P.gqk + (size_t)(sbase + trow) * 512 + col); }
#pragma unroll
        for (int i = 0; i < 3; ++i) { const int idx = tid + 256 * i; const int rr = idx >> 3, ch = idx & 7; const int tr = t0c - 1 + rr;
            if (idx < 528 && tr >= 0 && tr < L) prev[i] = *(const u32x4*)(P.p + (size_t)(sbase + tr) * INW + P_GV + h * 64 + ch * 8); else prev[i] = (u32x4){0u, 0u, 0u, 0u}; }
        if (tid < 64) { const bf16_t* pr = P.p + (size_t)(sbase + t0c + tid) * INW; pab = (unsigned)pr[P_BETA + dir * 4 + h] | ((unsigned)pr[P_A + dir * 4 + h] << 16); }
    };
    issue(0);
    for (int ci = 0; ci < 36; ++ci) {
        asm volatile("" : "+v"(tid));
        const int lane = tid & 63, lr = lane & 15, quad = lane >> 4;
        int sbase = 0, L = 0, t0c = 0; bool isctx = false;
        chunk_info(ci, sbase, L, t0c, isctx);
        __syncthreads();
#pragma unroll
        for (int i = 0; i < 4; ++i) { const int idx = tid + 256 * i; const int row = idx >> 4, part = idx & 15;
            if (part < 8) *(u32x4*)(Qh + row * 72 + part * 8) = preqk[i]; else *(u32x4*)(Kh + row * 72 + (part - 8) * 8) = preqk[i]; }
#pragma unroll
        for (int i = 0; i < 3; ++i) { const int idx = tid + 256 * i; if (idx < 528) *(u32x4*)(rawv + idx * 8) = prev[i]; }
        if (tid < 192) cwv[tid] = cwreg;
        if (tid < 64) { const int i = dir ? 63 - tid : tid;
            const float braw = __uint_as_float(pab << 16), araw = __uint_as_float(pab & 0xffff0000u);
            const float av = araw + dtb; const float sp = (av > 20.f) ? av : __logf(1.f + __expf(av));
            float g = neg_ea * sp; gsc[i] = g; gsc[128 + i] = sigmoid_f(braw);
#pragma unroll
            for (int o = 1; o < 64; o <<= 1) { const float t = dir ? __shfl_down(g, o) : __shfl_up(g, o); if (dir ? (tid + o < 64) : (tid >= o)) g += t; }
            gsc[64 + i] = g; gsc[192 + i] = __expf(g); }
        __syncthreads();
        if (ci + 1 < 36) issue(ci + 1);
        { const int rg = tid >> 2, c0 = (tid & 3) * 16, i = dir ? 63 - rg : rg;
#pragma unroll
          for (int hf = 0; hf < 2; ++hf) { float x0[8], x1[8], x2[8], yv[8];
              unpack8(*(const u32x4*)(rawv + rg * 64 + c0 + hf * 8), x0); unpack8(*(const u32x4*)(rawv + (rg + 1) * 64 + c0 + hf * 8), x1); unpack8(*(const u32x4*)(rawv + (rg + 2) * 64 + c0 + hf * 8), x2);
#pragma unroll
              for (int q = 0; q < 8; ++q) { const int c = c0 + hf * 8 + q; yv[q] = silu_f(cwv[c] * x0[q] + cwv[64 + c] * x1[q] + cwv[128 + c] * x2[q]); }
              *(u32x4*)(Vt + i * 72 + c0 + hf * 8) = (u32x4){cvt_pk_bf16(yv[0], yv[1]), cvt_pk_bf16(yv[2], yv[3]), cvt_pk_bf16(yv[4], yv[5]), cvt_pk_bf16(yv[6], yv[7])}; } }
        __syncthreads();
        const float gc_last = gsc[64 + 63], g_last = gsc[192 + 63];
        { const int i = tid >> 2, part = tid & 3; const float sc = __expf(gc_last - gsc[64 + i]);
          float kv[16]; unpack8(*(const u32x4*)(Kh + i * 72 + part * 16), kv); unpack8(*(const u32x4*)(Kh + i * 72 + part * 16 + 8), kv + 8);
#pragma unroll
          for (int q = 0; q < 16; ++q) Kdt[(part * 16 + q) * 72 + i] = f2bf(kv[q] * sc); }
        {
            f32x4 kk[4], qk[4];
#pragma unroll
            for (int nb = 0; nb < 4; ++nb) { kk[nb] = (f32x4){0.f, 0.f, 0.f, 0.f}; qk[nb] = (f32x4){0.f, 0.f, 0.f, 0.f}; }
#pragma unroll
            for (int ks = 0; ks < 2; ++ks) {
                const bf16x8 ak = *(const bf16x8*)(Kh + (16 * w + lr) * 72 + ks * 32 + quad * 8), aq = *(const bf16x8*)(Qh + (16 * w + lr) * 72 + ks * 32 + quad * 8);
#pragma unroll
                for (int nb = 0; nb < 4; ++nb) if (nb <= w) { const bf16x8 bj = *(const bf16x8*)(Kh + (16 * nb + lr) * 72 + ks * 32 + quad * 8);
                    kk[nb] = __builtin_amdgcn_mfma_f32_16x16x32_bf16(bj, ak, kk[nb], 0, 0, 0); qk[nb] = __builtin_amdgcn_mfma_f32_16x16x32_bf16(bj, aq, qk[nb], 0, 0, 0); }
            }
            const int i = 16 * w + lr; const float gci = gsc[64 + i], bi = gsc[128 + i];
#pragma unroll
            for (int nb = 0; nb < 4; ++nb) { f32x4 mv, av;
#pragma unroll
                for (int jj = 0; jj < 4; ++jj) { const int j = 16 * nb + quad * 4 + jj; const float dec = (i >= j) ? __expf(gci - gsc[64 + j]) : 0.f;
                    mv[jj] = (i > j) ? -bi * kk[nb][jj] * dec : 0.f; av[jj] = qk[nb][jj] * dec; }
                *(u32x2*)(nM + i * 72 + 16 * nb + quad * 4) = (u32x2){cvt_pk_bf16(mv[0], mv[1]), cvt_pk_bf16(mv[2], mv[3])};
                *(u32x2*)(At + i * 72 + 16 * nb + quad * 4) = (u32x2){cvt_pk_bf16(av[0], av[1]), cvt_pk_bf16(av[2], av[3])}; }
        }
        __syncthreads();
        {
            const bf16x4 nf = __builtin_bit_cast(bf16x4, *(const u32x2*)(nM + (16 * w + lr) * 72 + 16 * w + quad * 4));
            f32x4 pw, sum;
#pragma unroll
            for (int jj = 0; jj < 4; ++jj) { pw[jj] = bf2f(nM[(16 * w + quad * 4 + jj) * 72 + 16 * w + lr]); sum[jj] = pw[jj] + ((quad * 4 + jj == lr) ? 1.f : 0.f); }
#pragma unroll
            for (int k = 2; k < 16; ++k) { pw = __builtin_amdgcn_mfma_f32_16x16x16bf16_1k(nf, pack4(pw), (f32x4){0.f, 0.f, 0.f, 0.f}, 0, 0, 0); sum += pw; }
#pragma unroll
            for (int jj = 0; jj < 4; ++jj) nM[(16 * w + quad * 4 + jj) * 72 + 16 * w + lr] = f2bf(sum[jj]);
        }
        f32x4 X[4][2];
#pragma unroll
        for (int bb = 0; bb < 4; ++bb)
#pragma unroll
            for (int nb = 0; nb < 2; ++nb)
#pragma unroll
                for (int jj = 0; jj < 4; ++jj) { const int i = 16 * bb + quad * 4 + jj; const int n = 32 * (w & 1) + 16 * nb + lr;
                    X[bb][nb][jj] = (w < 2) ? gsc[128 + i] * bf2f(Vt[i * 72 + n]) : gsc[128 + i] * gsc[192 + i] * bf2f(Kh[i * 72 + n]); }
        __syncthreads();
        {
            bf16x4 Xb[4][2];
#pragma unroll
            for (int bb = 0; bb < 4; ++bb) {
#pragma unroll
                for (int bp = 0; bp < bb; ++bp) { const bf16x4 lf = __builtin_bit_cast(bf16x4, *(const u32x2*)(nM + (16 * bb + lr) * 72 + 16 * bp + quad * 4));
#pragma unroll
                    for (int nb = 0; nb < 2; ++nb) X[bb][nb] = __builtin_amdgcn_mfma_f32_16x16x16bf16_1k(lf, Xb[bp][nb], X[bb][nb], 0, 0, 0); }
                const bf16x4 df = __builtin_bit_cast(bf16x4, *(const u32x2*)(nM + (16 * bb + lr) * 72 + 16 * bb + quad * 4));
#pragma unroll
                for (int nb = 0; nb < 2; ++nb) { const bf16x4 zb = pack4(X[bb][nb]);
                    X[bb][nb] = __builtin_amdgcn_mfma_f32_16x16x16bf16_1k(df, zb, (f32x4){0.f, 0.f, 0.f, 0.f}, 0, 0, 0); Xb[bb][nb] = pack4(X[bb][nb]); }
            }
#pragma unroll
            for (int bb = 0; bb < 4; ++bb)
#pragma unroll
                for (int nb = 0; nb < 2; ++nb) { const int n = 32 * (w & 1) + 16 * nb + lr, i0 = 16 * bb + quad * 4;
                    if (w < 2) *(u32x2*)(Vt + n * 72 + i0) = __builtin_bit_cast(u32x2, Xb[bb][nb]);
                    else {
#pragma unroll
                        for (int jj = 0; jj < 4; ++jj) Kh[(i0 + jj) * 72 + n] = (bf16_t)Xb[bb][nb][jj]; } }
        }
        __syncthreads();
        {
            f32x4 acc[4];
#pragma unroll
            for (int nb = 0; nb < 4; ++nb) acc[nb] = (f32x4){0.f, 0.f, 0.f, 0.f};
#pragma unroll
            for (int ks = 0; ks < 2; ++ks) { const bf16x8 se = *(const bf16x8*)(St + (16 * w + lr) * 72 + ks * 32 + quad * 8);
#pragma unroll
                for (int nb = 0; nb < 4; ++nb) { const bf16x8 wi = *(const bf16x8*)(Kh + (16 * nb + lr) * 72 + ks * 32 + quad * 8);
                    acc[nb] = __builtin_amdgcn_mfma_f32_16x16x32_bf16(wi, se, acc[nb], 0, 0, 0); } }
            const int e = 16 * w + lr;
            f32x4 vn[4];
#pragma unroll
            for (int nb = 0; nb < 4; ++nb) vn[nb] = unpack4(*(const u32x2*)(Vt + e * 72 + 16 * nb + quad * 4)) - acc[nb];
            __syncthreads();
#pragma unroll
            for (int nb = 0; nb < 4; ++nb) *(u32x2*)(nM + e * 72 + 16 * nb + quad * 4) = (u32x2){cvt_pk_bf16(vn[nb][0], vn[nb][1]), cvt_pk_bf16(vn[nb][2], vn[nb][3])};
        }
        __syncthreads();
        {
            f32x4 o1[4], o2[4], sa[4];
#pragma unroll
            for (int nb = 0; nb < 4; ++nb) { o1[nb] = (f32x4){0.f, 0.f, 0.f, 0.f}; o2[nb] = (f32x4){0.f, 0.f, 0.f, 0.f}; sa[nb] = (f32x4){0.f, 0.f, 0.f, 0.f}; }
#pragma unroll
            for (int ks = 0; ks < 2; ++ks) {
                const bf16x8 bq = *(const bf16x8*)(Qh + (16 * w + lr) * 72 + ks * 32 + quad * 8), ba = *(const bf16x8*)(At + (16 * w + lr) * 72 + ks * 32 + quad * 8);
                const bf16x8 bv = *(const bf16x8*)(nM + (16 * w + lr) * 72 + ks * 32 + quad * 8);
#pragma unroll
                for (int nb = 0; nb < 4; ++nb) {
                    const bf16x8 as_ = *(const bf16x8*)(St + (16 * nb + lr) * 72 + ks * 32 + quad * 8), av = *(const bf16x8*)(nM + (16 * nb + lr) * 72 + ks * 32 + quad * 8);
                    const bf16x8 ak = *(const bf16x8*)(Kdt + (16 * nb + lr) * 72 + ks * 32 + quad * 8);
                    o1[nb] = __builtin_amdgcn_mfma_f32_16x16x32_bf16(as_, bq, o1[nb], 0, 0, 0);
                    o2[nb] = __builtin_amdgcn_mfma_f32_16x16x32_bf16(av, ba, o2[nb], 0, 0, 0);
                    sa[nb] = __builtin_amdgcn_mfma_f32_16x16x32_bf16(ak, bv, sa[nb], 0, 0, 0);
                }
            }
            { const int i = 16 * w + lr; const float eg = gsc[192 + i]; const int t = t0c + (dir ? 63 - i : i);
                bf16_t* orow = P.r2 + ((size_t)(0 * 2 + dir) * MT + sbase + t) * 256 + h * 64;
#pragma unroll
                for (int nb = 0; nb < 4; ++nb) { const f32x4 ov = o1[nb] * eg + o2[nb];
                    *(u32x2*)(orow + 16 * nb + quad * 4) = (u32x2){cvt_pk_bf16(ov[0], ov[1]), cvt_pk_bf16(ov[2], ov[3])}; } }
#pragma unroll
            for (int nb = 0; nb < 4; ++nb) Sreg[nb] = Sreg[nb] * g_last + sa[nb];
            __syncthreads();
            const int e = 16 * w + lr;
#pragma unroll
            for (int nb = 0; nb < 4; ++nb) *(u32x2*)(St + e * 72 + 16 * nb + quad * 4) = (u32x2){cvt_pk_bf16(Sreg[nb][0], Sreg[nb][1]), cvt_pk_bf16(Sreg[nb][2], Sreg[nb][3])};
        }
    }
    __syncthreads();
    __builtin_amdgcn_s_setprio(0);
}

__device__ void hgrn_chunked(const Params& P, int layer, int item, char* lds) {
    const int tid0 = opaque_tid(), w = __builtin_amdgcn_readfirstlane(tid0 >> 6);
    const int dir = item & 1, h = (item >> 1) & 3, b = item >> 3;
    constexpr int TSE = 64 * 72;
    bf16_t* qraw = (bf16_t*)lds;
    bf16_t* zraw = qraw + 4096;
    bf16_t* Qt = zraw + 4096;
    bf16_t* Kt = Qt + TSE;
    bf16_t* Qs = Kt + TSE;
    bf16_t* KdT = Qs + TSE;
    bf16_t* VT = KdT + TSE;
    float* gt = (float*)(VT + TSE);
    bf16_t* Ab = qraw;
    float lb;
    { const int d = tid0 & 63; const float r0 = P.hgrn_lb_raw[(0 * 2 + dir) * 256 + h * 64 + d], r1 = P.hgrn_lb_raw[(1 * 2 + dir) * 256 + h * 64 + d];
      const float mx = fmaxf(r0, r1), e0 = __expf(r0 - mx), e1 = __expf(r1 - mx); lb = (layer == 0) ? 0.f : e1 / (e0 + e1); }
    f32x4 Sreg[4];
#pragma unroll
    for (int nb = 0; nb < 4; ++nb) Sreg[nb] = (f32x4){0.f, 0.f, 0.f, 0.f};
    u32x4 pre[6];
    int tid = tid0;
    auto chunk_info = [&](int ci, int& sbase, int& t0c, bool& isctx) {
        isctx = ci < 4; const int n = isctx ? 4 : 32; int cj = isctx ? ci : ci - 4; if (dir) cj = n - 1 - cj;
        sbase = isctx ? (ML + b * CTX) : (b * SEQ); t0c = cj * 64;
    };
    auto issue = [&](int ci) {
        int sbase, t0c; bool isctx; chunk_info(ci, sbase, t0c, isctx);
#pragma unroll
        for (int i = 0; i < 6; ++i) { const int idx = tid + 256 * i; const int row = idx / 24, rem = idx % 24, seg = rem >> 3, ch = rem & 7;
            const int col = (seg == 0 ? P_HQ : (seg == 1 ? P_HF + dir * 256 : P_HI)) + h * 64 + ch * 8; const int trow = t0c + (dir ? 63 - row : row);
            pre[i] = *(const u32x4*)(P.p + (size_t)(sbase + trow) * INW + col); }
    };
    issue(0);
    for (int ci = 0; ci < 36; ++ci) {
        asm volatile("" : "+v"(tid));
        const int lane = tid & 63, lr = lane & 15, quad = lane >> 4;
        int sbase, t0c; bool isctx; chunk_info(ci, sbase, t0c, isctx);
        __syncthreads();
#pragma unroll
        for (int i = 0; i < 6; ++i) { const int idx = tid + 256 * i; const int row = idx / 24, rem = idx % 24, seg = rem >> 3, ch = rem & 7;
            if (seg == 0) *(u32x4*)(qraw + row * 64 + ch * 8) = pre[i];
            else if (seg == 1) *(u32x4*)(zraw + row * 64 + ch * 8) = pre[i];
            else {
#pragma unroll
                for (int q = 0; q < 4; ++q) { VT[(ch * 8 + 2 * q) * 72 + row] = (bf16_t)(pre[i][q] & 0xffffu); VT[(ch * 8 + 2 * q + 1) * 72 + row] = (bf16_t)(pre[i][q] >> 16); } } }
        __syncthreads();
        if (ci + 1 < 36) issue(ci + 1);
        { const int d = tid & 63, sc = tid >> 6;
          float bcv[16], qv[16], kv[16]; float c = 0.f;
#pragma unroll
          for (int r = 0; r < 16; ++r) { const int i = 16 * sc + r; float z = bf2f(zraw[i * 64 + d]); z = fminf(fmaxf(z, -30.f), 30.f);
              const float ez = __expf(-z), sg = __builtin_amdgcn_rcpf(1.f + ez); const float f = lb + (1.f - lb) * sg;
              c += __logf(f); bcv[r] = c; kv[r] = (1.f - lb) * ez * sg; qv[r] = silu_f(bf2f(qraw[i * 64 + d])); }
          const float m = bcv[7], last = c, em = __expf(m), elm = __expf(last - m);
          float kd[16];
#pragma unroll
          for (int r = 0; r < 16; ++r) { const int i = 16 * sc + r; const float E1 = __expf(bcv[r] - m), E2 = __expf(m - bcv[r]);
              const float q1 = qv[r] * E1, k2 = kv[r] * E2;
              Qt[i * 72 + d] = f2bf(q1); Kt[i * 72 + d] = f2bf(k2); Qs[i * 72 + d] = f2bf(q1 * em); kd[r] = k2 * elm; }
          *(u32x4*)(KdT + d * 72 + 16 * sc) = (u32x4){cvt_pk_bf16(kd[0], kd[1]), cvt_pk_bf16(kd[2], kd[3]), cvt_pk_bf16(kd[4], kd[5]), cvt_pk_bf16(kd[6], kd[7])};
          *(u32x4*)(KdT + d * 72 + 16 * sc + 8) = (u32x4){cvt_pk_bf16(kd[8], kd[9]), cvt_pk_bf16(kd[10], kd[11]), cvt_pk_bf16(kd[12], kd[13]), cvt_pk_bf16(kd[14], kd[15])};
          gt[sc * 64 + d] = __expf(last); }
        __syncthreads();
        { f32x4 a = (f32x4){0.f, 0.f, 0.f, 0.f};
#pragma unroll
          for (int ks = 0; ks < 2; ++ks) { const bf16x8 kj = *(const bf16x8*)(Kt + (16 * w + lr) * 72 + ks * 32 + quad * 8), qi = *(const bf16x8*)(Qt + (16 * w + lr) * 72 + ks * 32 + quad * 8);
              a = __builtin_amdgcn_mfma_f32_16x16x32_bf16(kj, qi, a, 0, 0, 0); }
#pragma unroll
          for (int jj = 0; jj < 4; ++jj) if (quad * 4 + jj > lr) a[jj] = 0.f;
          *(u32x2*)(Ab + (16 * w + lr) * 24 + quad * 4) = (u32x2){cvt_pk_bf16(a[0], a[1]), cvt_pk_bf16(a[2], a[3])}; }
        __syncthreads();
#pragma unroll 1
        for (int sc = 0; sc < 4; ++sc) {
            f32x4 o = (f32x4){0.f, 0.f, 0.f, 0.f};
#pragma unroll
            for (int ks = 0; ks < 2; ++ks) {
                const u32x2 s0 = __builtin_bit_cast(u32x2, pack4(Sreg[2 * ks])), s1 = __builtin_bit_cast(u32x2, pack4(Sreg[2 * ks + 1]));
                const bf16x8 sa = __builtin_bit_cast(bf16x8, (u32x4){s0[0], s0[1], s1[0], s1[1]});
                const u32x2 q0 = *(const u32x2*)(Qs + (16 * sc + lr) * 72 + 32 * ks + 4 * quad), q1 = *(const u32x2*)(Qs + (16 * sc + lr) * 72 + 32 * ks + 16 + 4 * quad);
                const bf16x8 qb = __builtin_bit_cast(bf16x8, (u32x4){q0[0], q0[1], q1[0], q1[1]});
                o = __builtin_amdgcn_mfma_f32_16x16x32_bf16(sa, qb, o, 0, 0, 0);
            }
            const bf16x4 vt = __builtin_bit_cast(bf16x4, *(const u32x2*)(VT + (16 * w + lr) * 72 + 16 * sc + quad * 4));
            const bf16x4 ab = __builtin_bit_cast(bf16x4, *(const u32x2*)(Ab + (16 * sc + lr) * 24 + quad * 4));
            o = __builtin_amdgcn_mfma_f32_16x16x16bf16_1k(vt, ab, o, 0, 0, 0);
            { const int i = 16 * sc + lr; const int t = t0c + (dir ? 63 - i : i);
                *(u32x2*)(P.r2 + ((size_t)(1 * 2 + dir) * MT + sbase + t) * 256 + h * 64 + 16 * w + quad * 4) = (u32x2){cvt_pk_bf16(o[0], o[1]), cvt_pk_bf16(o[2], o[3])}; }
#pragma unroll
            for (int nb = 0; nb < 4; ++nb) {
                const bf16x4 kf = __builtin_bit_cast(bf16x4, *(const u32x2*)(KdT + (16 * nb + lr) * 72 + 16 * sc + quad * 4));
                const f32x4 upd = __builtin_amdgcn_mfma_f32_16x16x16bf16_1k(kf, vt, (f32x4){0.f, 0.f, 0.f, 0.f}, 0, 0, 0);
                const f32x4 gv = *(const f32x4*)(gt + sc * 64 + 16 * nb + quad * 4);
                Sreg[nb] = Sreg[nb] * gv + upd;
            }
        }
    }
    __syncthreads();
}

__device__ void scanfin_row(const Params& P, int layer, int row, int lane) {
    const int hcol = lane * 4;
#pragma unroll
    for (int mx = 0; mx < 2; ++mx) {
        const uint2 uf = *(const uint2*)(P.r2 + ((size_t)(mx * 2 + 0) * MT + row) * 256 + hcol), ub = *(const uint2*)(P.r2 + ((size_t)(mx * 2 + 1) * MT + row) * 256 + hcol);
        float o[4];
        o[0] = __uint_as_float(uf.x << 16) + __uint_as_float(ub.x << 16); o[1] = __uint_as_float(uf.x & 0xffff0000u) + __uint_as_float(ub.x & 0xffff0000u);
        o[2] = __uint_as_float(uf.y << 16) + __uint_as_float(ub.y << 16); o[3] = __uint_as_float(uf.y & 0xffff0000u) + __uint_as_float(ub.y & 0xffff0000u);
        float ss = o[0] * o[0] + o[1] * o[1] + o[2] * o[2] + o[3] * o[3];
#pragma unroll
        for (int k = 8; k >= 1; k >>= 1) ss += __shfl_xor(ss, k);
        const float rstd = rsqrtf(ss * (1.f / 64.f) + EPS);
        const float* gain = (mx ? P.hgrn_norm : P.gdn_norm) + layer * 64 + (hcol & 63);
        const uint2 ug = *(const uint2*)(P.p + (size_t)row * INW + (mx ? P_HG : P_GZ) + hcol);
        float gt[4] = {__uint_as_float(ug.x << 16), __uint_as_float(ug.x & 0xffff0000u), __uint_as_float(ug.y << 16), __uint_as_float(ug.y & 0xffff0000u)};
        float r[4];
#pragma unroll
        for (int k = 0; k < 4; ++k) r[k] = o[k] * rstd * gain[k] * silu_f(gt[k]);
        uint2 ov; ov.x = cvt_pk_bf16(r[0], r[1]); ov.y = cvt_pk_bf16(r[2], r[3]);
        *(uint2*)(P.hm + (size_t)row * D + (mx ? 768 : 0) + hcol) = ov;
    }
}

#ifdef DBG_STOP
__device__ void dbg_dump(const Params& P, int k) {
    for (size_t i = (size_t)blockIdx.x * 256 + threadIdx.x; i < (size_t)ML * D; i += (size_t)gridDim.x * 256) {
        const int r = (int)(i >> 10), c = (int)(i & 1023);
        float v = 0.f;
        if (k == 1 || k == 5) v = bf2f(P.hm[(size_t)r * D + c]) + ((r < MC) ? bf2f(P.hm[(size_t)(ML + r) * D + c]) : 0.f);
        else if (k == 2 || k == 3) v = bf2f(P.p[(size_t)r * INW + c * 3]) + bf2f(P.p[(size_t)r * INW + c * 3 + 272]) + ((r < MC) ? bf2f(P.p[(size_t)(ML + r) * INW + c * 3]) : 0.f)
                                     + ((k == 3) ? bf2f(P.vt[(size_t)r * 2304 + c * 2]) : 0.f);
        else if (k == 4) v = (c >= 256 && c < 768) ? bf2f(P.hm[(size_t)r * D + c]) : bf2f(P.r2[((size_t)(c >> 8) * MT + r) * 256 + (c & 255)]) + bf2f(P.r2[((size_t)((c >> 8) + 1) * MT + r) * 256 + (c & 255)]);
        else if (k == 6) v = ((const float*)P.p)[(size_t)r * D + c];
        else if (k == 7) v = P.out[i] + bf2f(P.hm[(size_t)r * D + c]);
        else if (k == 8) v = bf2f(P.p[(size_t)r * FF + c * 2]) + bf2f(P.p[(size_t)r * FF + c + 1700]);
        else if (k == 9) v = bf2f(P.r2[(size_t)r * D + c]);
        else if (k == 0) v = (c < 864 ? P.mod[(size_t)(r % 18) * NMOD + (r / 18) * 6 % 5000 + c] : 0.f) + bf2f(P.w_inT[(size_t)(r % INP) * D + c]) + bf2f(P.w_upT[(size_t)(r % FF2) * D + c]) + bf2f(P.w_downT[(size_t)(r % D) * FF + c * 2]) + bf2f(P.w_outT[(size_t)(r % D) * D + c]);
        if (k != 7) P.out[i] = v; else P.out[i] = v;
    }
}
#define DBG_CHECK(k, l) if (DBG_STOP == (k) && (l) == DBG_LAYER) { dbg_dump(P, k); return; }
#else
#define DBG_CHECK(k, l)
#endif

__global__ void __launch_bounds__(256, 2) mega(Params P) {
    extern __shared__ __attribute__((aligned(16))) char lds[];
    __shared__ uint4 xb_words;
    __shared__ int s_item;
    cg::grid_group grid = cg::this_grid();
    const int tid = threadIdx.x, wid = tid >> 6, lane = tid & 63;
    if (tid == 0) xb_words = make_uint4(0u, 0u, 0u, 0u);
    __syncthreads();
    XcdBarrier xb = xcd_barrier_post(P.bar, (volatile LAS unsigned*)&xb_words);

    for (int it = blockIdx.x; it < 864 + ADA_ITEMS; it += gridDim.x) {
        if (it < ADA_ITEMS) ada_item(P, it, (float*)lds); else convert_item(P, 0, it - ADA_ITEMS, (float*)lds);
    }
    if (P.bar == nullptr) grid.sync();
    xcd_barrier(xb);
    DBG_CHECK(0, 0)
    resnorm_phase(P, 0, 0, MT);
    xcd_barrier(xb);
    DBG_CHECK(1, 0)

    for (int layer = 0; layer < 2; ++layer) {
        const bool with_ctx = layer == 0;
        const int Mrows = with_ctx ? MT : ML;
#ifndef NO_G1
        gemm_phase<EPI_P>(P.hm, D, MT, P.w_inT, D, INP / 128, P.p, INW, INW, lds);
#endif
        xcd_barrier(xb);
        DBG_CHECK(2, layer)
        { float cwr[24];
          const float* cwp = P.gdn_conv_w + (size_t)layer * 3 * 768 + (lane >> 5) * 256 + (lane & 31) * 8;
#pragma unroll
          for (int q = 0; q < 8; ++q) { cwr[q] = cwp[q]; cwr[8 + q] = cwp[768 + q]; cwr[16 + q] = cwp[1536 + q]; }
          for (int it = blockIdx.x; it < 4608; it += gridDim.x) { qkprep_rows(P, layer, it * 4 + wid, lane); gdnprep_row(P, layer, it * 4 + wid, lane, cwr); } }
        for (int it = blockIdx.x; it < VT_ITEMS; it += gridDim.x) vt_item(P, it, lds);
        xcd_barrier(xb);
        DBG_CHECK(3, layer)
        {
            const int n_scan = 128, n_attn_lat = 1024, n_attn_ctx = with_ctx ? 128 : 0;
            const int n_attn = n_scan + n_attn_lat + n_attn_ctx;
            const int n_conv = (layer == 0) ? (CONV_ITEMS - 864) + 864 : (CONV_ITEMS - 864);
            const int total = n_attn + n_conv;
            unsigned* ctr = P.ctr + layer * 64;
            for (;;) {
                __syncthreads();
                if (tid == 0) s_item = (int)atomicAdd(ctr, 1u);
                __syncthreads();
                const int it = s_item;
                if (it >= total) break;
                if (it >= n_attn) { const int cidx = it - n_attn;
                    if (layer == 0) { if (cidx < CONV_ITEMS - 864) convert_item(P, 0, 864 + cidx, (float*)lds); else convert_item(P, 1, cidx - (CONV_ITEMS - 864), (float*)lds); }
                    else convert_item(P, 1, 864 + cidx, (float*)lds);
                    continue; }
                if (it < 64) {
                    gdn_chunked(P, layer, it, lds);
                } else if (it < 128) {
                    hgrn_chunked(P, layer, it - 64, lds);
                }
#ifndef NO_ATTN
                else if (it < 128 + 1024) { const int a = it - 128; const int type = a >> 9, r = a & 511; attn_item(P, layer, type, r >> 6, (r >> 5) & 1, r & 31, false, lds); }
                else { const int a = it - 1152; const int type = a >> 6, r = a & 63; attn_item(P, layer, type, r >> 3, (r >> 2) & 1, r & 3, true, lds); }
#endif
            }
        }
        xcd_barrier(xb);
        DBG_CHECK(4, layer)
        for (int row = blockIdx.x * 4 + wid; row < Mrows; row += gridDim.x * 4) scanfin_row(P, layer, row, lane);
        xcd_barrier(xb);
        DBG_CHECK(5, layer)
#ifndef NO_G2
        gemm_phase<EPI_F32>(P.hm, D, Mrows, P.w_outT, D, D / 128, (void*)P.p, D, D, lds);
#endif
        xcd_barrier(xb);
        DBG_CHECK(6, layer)
        resnorm_phase(P, layer, 1, Mrows);
        xcd_barrier(xb);
        DBG_CHECK(7, layer)
#ifndef NO_G3
        ffnup_phase(P, layer, with_ctx, lds);
#endif
        xcd_barrier(xb);
        DBG_CHECK(8, layer)
#ifndef NO_G4
        gemm_phase<EPI_BF16>(P.p, FF, Mrows, P.w_downT, FF, D / 128, (void*)P.r2, D, D, lds);
#endif
        xcd_barrier(xb);
        DBG_CHECK(9, layer)
        resnorm_phase(P, layer, 2, Mrows);
        if (layer == 0) {
            xcd_barrier(xb);
        }
    }
}

extern "C" void kernel_launch(void* const* d_in, const int* in_sizes, int n_in, void* d_out, int out_size, void* d_ws, size_t ws_size, hipStream_t stream) {
    Params P{};
    const float* const* in = (const float* const*)d_in;
    P.x = in[0]; P.c = in[1]; P.ctx = in[2]; P.c_ctx = in[3]; P.ada_w = in[4]; P.ada_b = in[5]; P.n_pre_mix = in[6]; P.n_post_mix = in[7]; P.n_pre_ffn = in[8]; P.n_post_ffn = in[9];
    P.w_in = in[10]; P.w_out = in[11]; P.gdn_conv_w = in[12]; P.gdn_a_log = in[13]; P.gdn_dt_bias = in[14]; P.gdn_norm = in[15]; P.attn_q_norm = in[16]; P.attn_k_norm = in[17];
    P.swa_sink = in[18]; P.hgrn_lb_raw = in[19]; P.hgrn_norm = in[20]; P.ffn_w_up = in[21]; P.ffn_conv_w = in[22]; P.ffn_conv_b = in[23]; P.ffn_w_down = in[24];
    P.out = (float*)d_out;
    char* ws = (char*)d_ws; size_t off = 0;
    auto take = [&](size_t bytes) { char* p = ws + off; off += (bytes + 255) & ~(size_t)255; return p; };
    const size_t ctl_bytes = 16384 + 1024 + (size_t)2 * 9 * NMOD * 4;
    P.bar = (unsigned*)take(16384); P.ctr = (unsigned*)take(1024); P.mod = (float*)take((size_t)2 * 9 * NMOD * 4);
    const size_t ctl_total = off;
    P.w_inT = (bf16_t*)take((size_t)INP * D * 2); P.w_outT = (bf16_t*)take((size_t)D * D * 2); P.w_upT = (bf16_t*)take((size_t)FF2 * D * 2); P.w_downT = (bf16_t*)take((size_t)D * FF * 2);
    P.xc = (float*)take((size_t)MC * D * 4);
    P.hm = (bf16_t*)take((size_t)MT * D * 2);
    P.p = (bf16_t*)take((size_t)MT * INW * 2);
    P.r2 = (bf16_t*)take((size_t)MT * D * 2);
    P.vt = (bf16_t*)take((size_t)2 * 8 * 2 * 64 * VT_LD * 2);
    P.adapart = (float*)P.r2;
    P.gqk = (bf16_t*)take((size_t)MT * 512 * 2);
    (void)ctl_bytes;
    if (off > ws_size) { fprintf(stderr, "workspace too small: need %zu have %zu\n", off, ws_size); return; }
    (void)hipMemsetAsync(ws, 0, ctl_total, stream);
    static int grid_blocks = 0;
    if (!grid_blocks) {
        if (hipFuncSetAttribute((const void*)mega, hipFuncAttributeMaxDynamicSharedMemorySize, LDS_BYTES) != hipSuccess) { fprintf(stderr, "hipFuncSetAttribute failed\n"); return; }
        int dev = 0, cus = 0, per_cu = 0;
        (void)hipGetDevice(&dev);
        (void)hipDeviceGetAttribute(&cus, hipDeviceAttributeMultiprocessorCount, dev);
        (void)hipOccupancyMaxActiveBlocksPerMultiprocessor(&per_cu, (const void*)mega, 256, LDS_BYTES);
        if (per_cu > 2) per_cu = 2;
        if (per_cu < 1) per_cu = 1;
        grid_blocks = cus * per_cu;
    }
    void* args[] = {&P};
    hipError_t e = hipLaunchCooperativeKernel((const void*)mega, dim3(grid_blocks), dim3(256), args, LDS_BYTES, stream);
    if (e != hipSuccess) fprintf(stderr, "cooperative launch failed: %s (grid %d)\n", hipGetErrorString(e), grid_blocks);
}
```

```cpp
#include <hip/hip_runtime.h>
#include <hip/hip_cooperative_groups.h>
#include <cstdio>
#include <cstdint>
namespace cg = cooperative_groups;

typedef unsigned short bf16_t;
typedef short bf16x8 __attribute__((ext_vector_type(8)));
typedef float f32x4 __attribute__((ext_vector_type(4)));
typedef unsigned u32x4 __attribute__((ext_vector_type(4)));
#define LAS __attribute__((address_space(3)))

constexpr int D = 1024, NB = 8, SEQ = 2048, CTX = 256;
constexpr int ML = NB * SEQ, MC = NB * CTX, MT = ML + MC;
constexpr int INW = 3344, INP = 3456, FF = 2816, FF2 = 5632;
constexpr int NMOD = 6 * D;
constexpr int P_GQ = 0, P_GK = 256, P_GV = 512, P_GZ = 768, P_AQ = 1024, P_AK = 1280, P_AV = 1408, P_WQ = 1536, P_WK = 1792, P_WV = 1920,
              P_HQ = 2048, P_HF = 2304, P_HI = 2816, P_HG = 3072, P_BETA = 3328, P_A = 3336;
constexpr float EPS = 1e-6f;
constexpr int LDS_BYTES = 65536;
constexpr int VT_LD = CTX + SEQ;

struct Params {
    const float *x, *c, *ctx, *c_ctx, *ada_w, *ada_b, *n_pre_mix, *n_post_mix, *n_pre_ffn, *n_post_ffn, *w_in, *w_out, *gdn_conv_w, *gdn_a_log,
        *gdn_dt_bias, *gdn_norm, *attn_q_norm, *attn_k_norm, *swa_sink, *hgrn_lb_raw, *hgrn_norm, *ffn_w_up, *ffn_conv_w, *ffn_conv_b, *ffn_w_down;
    float* out;
    unsigned* bar;
    unsigned* ctr;
    float* mod;
    float* adapart;
    bf16_t *w_inT, *w_outT, *w_upT, *w_downT;
    float* xc;
    bf16_t* hm;
    bf16_t* p;
    bf16_t* r2;
    bf16_t* vt;
    bf16_t* gqk;
};

__device__ __forceinline__ float bf2f(bf16_t v) { return __uint_as_float(((unsigned)v) << 16); }
typedef __bf16 bf16v2 __attribute__((ext_vector_type(2)));
typedef float f32v2 __attribute__((ext_vector_type(2)));
__device__ __forceinline__ unsigned cvt_pk_bf16(float lo, float hi) { const f32v2 v = {lo, hi}; return __builtin_bit_cast(unsigned, __builtin_convertvector(v, bf16v2)); }
__device__ __forceinline__ bf16_t f2bf(float f) { return (bf16_t)(cvt_pk_bf16(f, 0.f) & 0xffffu); }
__device__ __forceinline__ float silu_f(float x) { return x * __builtin_amdgcn_rcpf(1.f + __expf(-x)); }
__device__ __forceinline__ float sigmoid_f(float x) { return __builtin_amdgcn_rcpf(1.f + __expf(-x)); }
__device__ __forceinline__ float wave_sum(float v) {
#pragma unroll
    for (int o = 32; o >= 1; o >>= 1) v += __shfl_xor(v, o);
    return v;
}
template <int CTRL> __device__ __forceinline__ float dpp_f(float x) {
    return __int_as_float(__builtin_amdgcn_update_dpp(0, __float_as_int(x), CTRL, 0xF, 0xF, true));
}
__device__ __forceinline__ float red8(float x) {
    x += dpp_f<0xB1>(x); x += dpp_f<0x4E>(x); x += dpp_f<0x141>(x); return x;
}
__device__ __forceinline__ void unpack8(u32x4 v, float* o) {
    o[0] = __uint_as_float(v[0] << 16); o[1] = __uint_as_float(v[0] & 0xffff0000u);
    o[2] = __uint_as_float(v[1] << 16); o[3] = __uint_as_float(v[1] & 0xffff0000u);
    o[4] = __uint_as_float(v[2] << 16); o[5] = __uint_as_float(v[2] & 0xffff0000u);
    o[6] = __uint_as_float(v[3] << 16); o[7] = __uint_as_float(v[3] & 0xffff0000u);
}

__device__ __forceinline__ int opaque_tid() { int t = threadIdx.x; asm volatile("" : "+v"(t)); return t; }
#define XB_TMO      128
#define XB_XCNT(j)  (256  + 64 * (j))
#define XB_XSUB(j)  (1280 + 64 * (j))
#define XB_XGEN(j)  (2304 + 64 * (j))
#define XB_TOP      3328
#define XB_TOPGEN   3392
#define XCD_BAR_WORDS 3456
#define XB_SPIN_CAP (1u << 22)
__device__ __forceinline__ unsigned xb_ld(unsigned* p)              { return __hip_atomic_load(p, __ATOMIC_RELAXED, __HIP_MEMORY_SCOPE_AGENT); }
__device__ __forceinline__ unsigned xb_add(unsigned* p, unsigned v) { return __hip_atomic_fetch_add(p, v, __ATOMIC_RELAXED, __HIP_MEMORY_SCOPE_AGENT); }
__device__ __forceinline__ unsigned xb_xcc_id() { return (unsigned)__builtin_amdgcn_s_getreg((3 << 11) | 20) & 0xFu; }
#define XB_SPIN(cond, bar) do { unsigned _sp = 0; while (cond) { __builtin_amdgcn_s_sleep(1); \
    if ((++_sp & 255u) == 0u) { if (xb_ld(&(bar)[XB_TMO])) break; if (_sp > XB_SPIN_CAP) { atomicAdd(&(bar)[XB_TMO], 1u); break; } } } } while (0)
struct XcdBarrier { unsigned* bar; unsigned x; volatile LAS unsigned* st; };
__device__ __forceinline__ XcdBarrier xcd_barrier_post(unsigned* bar, volatile LAS unsigned* st) {
    XcdBarrier b; b.bar = bar; b.x = xb_xcc_id(); b.st = st;
    if (threadIdx.x == 0) (void)xb_add(&bar[XB_XCNT(b.x)], 1u);
    return b;
}
__device__ __forceinline__ void xcd_barrier_complete(unsigned* bar, unsigned x, unsigned& nloc, unsigned& nx) {
    const unsigned G = gridDim.x * gridDim.y * gridDim.z;
    unsigned sum, cnt, mine, sp = 0u;
    for (;;) {
        sum = 0u; cnt = 0u; mine = 0u;
#pragma unroll
        for (unsigned j = 0; j < 16; ++j) { const unsigned c = xb_ld(&bar[XB_XCNT(j)]); sum += c; cnt += (c > 0u) ? 1u : 0u; mine = (j == x) ? c : mine; }
        if (sum == G) break;
        __builtin_amdgcn_s_sleep(1);
        if ((++sp & 255u) == 0u) { if (xb_ld(&bar[XB_TMO])) break; if (sp > XB_SPIN_CAP) { atomicAdd(&bar[XB_TMO], 1u); break; } }
    }
    nloc = mine > 0u ? mine : 1u; nx = cnt > 0u ? cnt : 1u;
}
__device__ __forceinline__ void xcd_barrier(const XcdBarrier& b) {
    asm volatile("s_waitcnt vmcnt(0)" ::: "memory");
    __syncthreads();
    if (threadIdx.x == 0) {
        unsigned* bar = b.bar;
        __builtin_amdgcn_s_waitcnt(0);
        unsigned nloc = b.st[0], nx = b.st[1];
        if (nloc == 0u) { xcd_barrier_complete(bar, b.x, nloc, nx); b.st[0] = nloc; b.st[1] = nx; }
        const unsigned old = xb_add(&bar[XB_XSUB(b.x)], 1u);
        const unsigned gen = old / nloc;
        if (old + 1u == (gen + 1u) * nloc) {
            __builtin_amdgcn_fence(__ATOMIC_RELEASE, "agent");
            asm volatile("s_waitcnt vmcnt(0)" ::: "memory");
            const unsigned og = xb_add(&bar[XB_TOP], 1u);
            const unsigned tg = og / nx;
            if (og + 1u == (tg + 1u) * nx) xb_add(&bar[XB_TOPGEN], 1u);
            else XB_SPIN(xb_ld(&bar[XB_TOPGEN]) == tg, bar);
            __builtin_amdgcn_fence(__ATOMIC_ACQUIRE, "agent");
            xb_add(&bar[XB_XGEN(b.x)], 1u);
            asm volatile("s_waitcnt vmcnt(0)" ::: "memory");
        } else {
            XB_SPIN(xb_ld(&bar[XB_XGEN(b.x)]) == gen, bar);
            __builtin_amdgcn_fence(__ATOMIC_ACQUIRE, "agent");
            asm volatile("s_waitcnt vmcnt(0)" ::: "memory");
        }
    }
    __syncthreads();
}

__device__ __forceinline__ void convert_tile(const float* __restrict__ W, int K, int N, bf16_t* __restrict__ Wt, int n0, int k0, int mode, float* tile) {
    const int tid = opaque_tid(), i = tid & 63, j = tid >> 6;
    const int n = n0 + i; int src = n;
    if (mode == 1) src = (n < 1024) ? n : (n < 3328 ? n + 16 : (n < 3344 ? 1024 + (n - 3328) : -1));
    else if (mode == 2) { const int blk = n >> 7, r = n & 127; src = (r < 64) ? blk * 64 + r : FF + blk * 64 + (r - 64); }
#pragma unroll 4
    for (int kk = 0; kk < 16; ++kk) { const int k = kk * 4 + j; const float v = (src >= 0) ? W[(size_t)(k0 + k) * N + src] : 0.f; tile[k * 65 + i] = v; }
    __syncthreads();
    const int nn = tid >> 2, ks = (tid & 3) * 16;
    unsigned w[8];
#pragma unroll
    for (int q = 0; q < 8; ++q) w[q] = cvt_pk_bf16(tile[(ks + 2 * q) * 65 + nn], tile[(ks + 2 * q + 1) * 65 + nn]);
    uint4* dst = (uint4*)(Wt + (size_t)(n0 + nn) * K + k0 + ks);
    dst[0] = make_uint4(w[0], w[1], w[2], w[3]); dst[1] = make_uint4(w[4], w[5], w[6], w[7]);
    __syncthreads();
}
constexpr int CONV_ITEMS = 864 + 256 + 1408 + 704;
__device__ void convert_item(const Params& P, int layer, int it, float* tile) {
    if (it < 864) { const int nt = it >> 4, kt = it & 15; convert_tile(P.w_in + (size_t)layer * D * INW, D, INW, P.w_inT, nt * 64, kt * 64, 1, tile); return; }
    it -= 864;
    if (it < 256) { const int nt = it >> 4, kt = it & 15; convert_tile(P.w_out + (size_t)layer * D * D, D, D, P.w_outT, nt * 64, kt * 64, 0, tile); return; }
    it -= 256;
    if (it < 1408) { const int nt = it >> 4, kt = it & 15; convert_tile(P.ffn_w_up + (size_t)layer * D * FF2, D, FF2, P.w_upT, nt * 64, kt * 64, 2, tile); return; }
    it -= 1408;
    { const int nt = it / 44, kt = it % 44; convert_tile(P.ffn_w_down + (size_t)layer * FF * D, FF, D, P.w_downT, nt * 64, kt * 64, 0, tile); }
}
constexpr int ADA_ITEMS = 2 * 24 * 16;
__device__ void ada_item(const Params& P, int item, float* lds) {
    const int tid = opaque_tid();
    const int kc = item & 15, cc = (item >> 4) % 24, layer = item / (16 * 24);
    for (int i = tid; i < 9 * 64; i += 256) { const int r = i >> 6, k = i & 63; const float v = (r < 8) ? P.c[r * D + kc * 64 + k] : P.c_ctx[kc * 64 + k]; lds[i] = silu_f(v); }
    __syncthreads();
    const int col = cc * 256 + tid;
    float acc[9];
#pragma unroll
    for (int r = 0; r < 9; ++r) acc[r] = 0.f;
    const float* w = P.ada_w + (size_t)layer * D * NMOD + (size_t)(kc * 64) * NMOD + col;
#pragma unroll 8
    for (int k = 0; k < 64; ++k) { const float wv = w[(size_t)k * NMOD];
#pragma unroll
        for (int r = 0; r < 9; ++r) acc[r] += lds[r * 64 + k] * wv; }
    float* part = P.adapart + (size_t)item * 9 * 256;
#pragma unroll
    for (int r = 0; r < 9; ++r) __hip_atomic_store(part + r * 256 + tid, acc[r], __ATOMIC_RELAXED, __HIP_MEMORY_SCOPE_AGENT);
    __threadfence();
    __syncthreads();
    unsigned* flag = (unsigned*)(lds + 600);
    if (tid == 0) { const unsigned old = __hip_atomic_fetch_add(P.ctr + 128 + layer * 24 + cc, 1u, __ATOMIC_ACQ_REL, __HIP_MEMORY_SCOPE_AGENT); *flag = old; }
    __syncthreads();
    const bool last = (*flag == 15u);
    if (last) {
        __threadfence();
        const float bb = P.ada_b[layer * NMOD + col];
#pragma unroll
        for (int r = 0; r < 9; ++r) { float sum = bb;
            for (int k2 = 0; k2 < 16; ++k2) sum += __hip_atomic_load(P.adapart + (size_t)((layer * 24 + cc) * 16 + k2) * 9 * 256 + r * 256 + tid, __ATOMIC_RELAXED, __HIP_MEMORY_SCOPE_AGENT);
            P.mod[(size_t)(layer * 9 + r) * NMOD + col] = sum; }
    }
    __syncthreads();
}

struct RowP { const float* xin; float* xout; const void* branch; const float *gate, *gpost, *gnext, *shift, *scale; bf16_t* hout; };
template <int BR>
__device__ __forceinline__ void rn_load(const RowP& r, f32x4 (&x)[4], f32x4 (&br)[4], int lane) {
#pragma unroll
    for (int g = 0; g < 4; ++g) x[g] = *(const f32x4*)(r.xin + g * 256 + lane * 4);
    if (BR != 0) {
#pragma unroll
        for (int g = 0; g < 4; ++g) {
            if (BR == 1) br[g] = *(const f32x4*)((const float*)r.branch + g * 256 + lane * 4);
            else { const uint2 u = *(const uint2*)((const bf16_t*)r.branch + g * 256 + lane * 4);
                   br[g] = (f32x4){__uint_as_float(u.x << 16), __uint_as_float(u.x & 0xffff0000u), __uint_as_float(u.y << 16), __uint_as_float(u.y & 0xffff0000u)}; }
        }
    }
}
template <int BR>
__device__ __forceinline__ void rn_compute(const RowP& r, f32x4 (&x)[4], f32x4 (&br)[4], int lane) {
    f32x4 gt[4], gp[4], gn[4], sh[4], sc[4];
    if (BR != 0) {
#pragma unroll
        for (int g = 0; g < 4; ++g) { gt[g] = *(const f32x4*)(r.gate + g * 256 + lane * 4); gp[g] = *(const f32x4*)(r.gpost + g * 256 + lane * 4); }
    }
    if (r.hout) {
#pragma unroll
        for (int g = 0; g < 4; ++g) { gn[g] = *(const f32x4*)(r.gnext + g * 256 + lane * 4); sh[g] = *(const f32x4*)(r.shift + g * 256 + lane * 4); sc[g] = *(const f32x4*)(r.scale + g * 256 + lane * 4); }
    }
    if (BR != 0) {
        float ss = 0.f;
#pragma unroll
        for (int g = 0; g < 4; ++g) ss += br[g][0] * br[g][0] + br[g][1] * br[g][1] + br[g][2] * br[g][2] + br[g][3] * br[g][3];
        ss = wave_sum(ss);
        const float rstd = rsqrtf(ss * (1.f / D) + EPS);
#pragma unroll
        for (int g = 0; g < 4; ++g) x[g] += gt[g] * (br[g] * rstd * gp[g]);
#pragma unroll
        for (int g = 0; g < 4; ++g) *(f32x4*)(r.xout + g * 256 + lane * 4) = x[g];
    }
    if (r.hout) {
        float ss = 0.f;
#pragma unroll
        for (int g = 0; g < 4; ++g) ss += x[g][0] * x[g][0] + x[g][1] * x[g][1] + x[g][2] * x[g][2] + x[g][3] * x[g][3];
        ss = wave_sum(ss);
        const float rstd = rsqrtf(ss * (1.f / D) + EPS);
#pragma unroll
        for (int g = 0; g < 4; ++g) { const f32x4 h = (x[g] * rstd * gn[g]) * (1.f + sc[g]) + sh[g];
            uint2 o; o.x = cvt_pk_bf16(h[0], h[1]); o.y = cvt_pk_bf16(h[2], h[3]);
            *(uint2*)(r.hout + g * 256 + lane * 4) = o; }
    }
}
template <int KIND>
__device__ __forceinline__ RowP rn_setup(const Params& P, int layer, int row) {
    const bool lat = row < ML;
    const int cond = lat ? (row >> 11) : 8;
    const float* modl = P.mod + (size_t)(layer * 9 + cond) * NMOD;
    bf16_t* h = P.hm + (size_t)row * D;
    RowP r{};
    if (KIND == 0) {
        r.xin = lat ? P.x + (size_t)row * D : P.ctx + (size_t)(row - ML) * D;
        r.gnext = P.n_pre_mix + layer * D; r.shift = modl; r.scale = modl + D; r.hout = h;
    } else if (KIND == 1) {
        r.xin = (layer == 0) ? (lat ? P.x + (size_t)row * D : P.ctx + (size_t)(row - ML) * D) : (lat ? P.out + (size_t)row * D : P.xc + (size_t)(row - ML) * D);
        r.xout = lat ? P.out + (size_t)row * D : P.xc + (size_t)(row - ML) * D;
        r.branch = P.p + (size_t)row * D; r.gate = modl + 2 * D; r.gpost = P.n_post_mix + layer * D;
        r.gnext = P.n_pre_ffn + layer * D; r.shift = modl + 3 * D; r.scale = modl + 4 * D; r.hout = h;
    } else {
        float* xo = lat ? P.out + (size_t)row * D : P.xc + (size_t)(row - ML) * D;
        const bool nxt = layer == 0;
        const float* modn = P.mod + (size_t)((layer + 1) * 9 + cond) * NMOD;
        r.xin = xo; r.xout = xo; r.branch = P.r2 + (size_t)row * D; r.gate = modl + 5 * D; r.gpost = P.n_post_ffn + layer * D;
        if (nxt) { r.gnext = P.n_pre_mix + (layer + 1) * D; r.shift = modn; r.scale = modn + D; r.hout = h; }
    }
    return r;
}
template <int KIND>
__device__ __forceinline__ void resnorm_loop(const Params& P, int layer, int nrows) {
    constexpr int BR = (KIND == 0) ? 0 : 2;
    const int tid_ = opaque_tid(); const int wid = tid_ >> 6, lane = tid_ & 63;
    const int stride = gridDim.x * 4;
    int row = blockIdx.x * 4 + wid;
    if (row >= nrows) return;
    f32x4 x[4], br[4];
    RowP cur = rn_setup<KIND>(P, layer, row);
    rn_load<BR>(cur, x, br, lane);
    for (;;) {
        const int nrow = row + stride;
        f32x4 xn[4], bn[4]; RowP nxt{};
        const bool more = nrow < nrows;
        if (more) { nxt = rn_setup<KIND>(P, layer, nrow); rn_load<BR>(nxt, xn, bn, lane); }
        rn_compute<BR>(cur, x, br, lane);
        if (!more) break;
#pragma unroll
        for (int g = 0; g < 4; ++g) { x[g] = xn[g]; br[g] = bn[g]; }
        cur = nxt; row = nrow;
    }
}
__device__ void resnorm_phase(const Params& P, int layer, int kind, int nrows) {
    if (kind == 0) resnorm_loop<0>(P, layer, nrows); else if (kind == 1) resnorm_loop<1>(P, layer, nrows); else resnorm_loop<2>(P, layer, nrows);
}

enum { EPI_P = 0, EPI_F32 = 1, EPI_BF16 = 2, EPI_FFNUP = 3 };
struct EpiArgs { void* out; int ldc; int ncols; const float* cw; const float* cb; int seq_lo, seq_hi, out_lo, out_hi, nblk; };
template <int EPI>
__device__ __forceinline__ void gemm_tile(const bf16_t* __restrict__ A, int lda, int arow_base, int arow_lo, int arow_hi, const bf16_t* __restrict__ Bt, int K, int n0,
                                          const EpiArgs& E, char* lds) {
    const int tid = opaque_tid(), wid = __builtin_amdgcn_readfirstlane(tid >> 6), lane = tid & 63, wm = wid >> 1, wn = wid & 1, lr = lane & 15, quad = lane >> 4;
    const int sr = tid >> 3, sc = (tid & 7) ^ (sr & 7);
    const bf16_t* ap[4]; const bf16_t* bp[4];
#pragma unroll
    for (int i = 0; i < 4; ++i) { int r = arow_base + sr + 32 * i; r = r < arow_lo ? arow_lo : (r >= arow_hi ? arow_hi - 1 : r);
        ap[i] = A + (size_t)r * lda + sc * 8; bp[i] = Bt + (size_t)(n0 + sr + 32 * i) * K + sc * 8; }
    LAS char* l3 = (LAS char*)lds;
    auto stage = [&](int kt, int buf) {
#pragma unroll
        for (int i = 0; i < 4; ++i) {
            __builtin_amdgcn_global_load_lds((const unsigned*)(ap[i] + kt * 64), (LAS unsigned*)(l3 + buf * 32768 + i * 4096 + wid * 1024), 16, 0, 0);
            __builtin_amdgcn_global_load_lds((const unsigned*)(bp[i] + kt * 64), (LAS unsigned*)(l3 + buf * 32768 + 16384 + i * 4096 + wid * 1024), 16, 0, 0);
        }
    };
    f32x4 acc[4][4];
#pragma unroll
    for (int mi = 0; mi < 4; ++mi)
#pragma unroll
        for (int ni = 0; ni < 4; ++ni) acc[mi][ni] = (f32x4){0.f, 0.f, 0.f, 0.f};
    const int nk = K >> 6;
    __syncthreads();
    stage(0, 0);
    for (int kt = 0; kt < nk; ++kt) {
        asm volatile("s_waitcnt vmcnt(0)" ::: "memory");
        __syncthreads();
        if (kt + 1 < nk) stage(kt + 1, (kt + 1) & 1);
        const char* As = lds + (kt & 1) * 32768; const char* Bs = As + 16384;
#pragma unroll
        for (int ks = 0; ks < 2; ++ks) {
            bf16x8 af[4], bfr[4];
            const int ch = ks * 4 + quad;
#pragma unroll
            for (int mi = 0; mi < 4; ++mi) { const int r = wm * 64 + mi * 16 + lr; af[mi] = *(const bf16x8*)(As + r * 128 + ((ch ^ (r & 7)) * 16)); }
#pragma unroll
            for (int ni = 0; ni < 4; ++ni) { const int r = wn * 64 + ni * 16 + lr; bfr[ni] = *(const bf16x8*)(Bs + r * 128 + ((ch ^ (r & 7)) * 16)); }
            __builtin_amdgcn_s_setprio(1);
#pragma unroll
            for (int mi = 0; mi < 4; ++mi)
#pragma unroll
                for (int ni = 0; ni < 4; ++ni) acc[mi][ni] = __builtin_amdgcn_mfma_f32_16x16x32_bf16(bfr[ni], af[mi], acc[mi][ni], 0, 0, 0);
            __builtin_amdgcn_s_setprio(0);
        }
    }
#ifdef EXP_A
    if (EPI == EPI_FFNUP) {
#pragma unroll
        for (int mi = 0; mi < 4; ++mi) { const int i = wm * 64 + mi * 16 + lr; const int grow = arow_base + i;
#pragma unroll
            for (int ni = 0; ni < 4; ++ni) if (wn == 0 && i >= 1 && i <= 126 && grow < E.out_hi) { uint2 o; o.x = cvt_pk_bf16(acc[mi][ni][0], acc[mi][ni][1]); o.y = cvt_pk_bf16(acc[mi][ni][2], acc[mi][ni][3]);
                *(uint2*)((bf16_t*)E.out + (size_t)grow * FF + E.nblk * 64 + ni * 16 + quad * 4) = o; } }
    } else
#endif
    if (EPI == EPI_FFNUP) {
        __syncthreads();
        bf16_t* U = (bf16_t*)lds;
#pragma unroll
        for (int mi = 0; mi < 4; ++mi)
#pragma unroll
            for (int ni = 0; ni < 4; ++ni) { uint2 o; o.x = cvt_pk_bf16(acc[mi][ni][0], acc[mi][ni][1]); o.y = cvt_pk_bf16(acc[mi][ni][2], acc[mi][ni][3]);
                *(uint2*)(U + (wm * 64 + mi * 16 + lr) * 136 + wn * 64 + ni * 16 + quad * 4) = o; }
        __syncthreads();
        auto ld4 = [&](int r, int c) { const uint2 u = *(const uint2*)(U + r * 136 + c);
            return (f32x4){__uint_as_float(u.x << 16), __uint_as_float(u.x & 0xffff0000u), __uint_as_float(u.y << 16), __uint_as_float(u.y & 0xffff0000u)}; };
        const int j4 = (tid & 15) * 4; const int f0 = E.nblk * 64 + j4;
        f32x4 wg[3], wv[3];
#pragma unroll
        for (int kk = 0; kk < 3; ++kk) { wg[kk] = *(const f32x4*)(E.cw + kk * FF2 + f0); wv[kk] = *(const f32x4*)(E.cw + kk * FF2 + FF + f0); }
        const f32x4 bg = *(const f32x4*)(E.cb + f0), bv = *(const f32x4*)(E.cb + FF + f0);
#pragma unroll
        for (int rr = 0; rr < 8; ++rr) {
            const int i = (tid >> 4) + 16 * rr; const int grow = arow_base + i;
            if (i >= 1 && i <= 126 && grow >= E.out_lo && grow < E.out_hi) {
                const float mp = (grow - 1 >= E.seq_lo) ? 1.f : 0.f, mn = (grow + 1 < E.seq_hi) ? 1.f : 0.f;
                const f32x4 gp = ld4(i - 1, j4), gc = ld4(i, j4), gn = ld4(i + 1, j4);
                const f32x4 vp = ld4(i - 1, 64 + j4), vc = ld4(i, 64 + j4), vn = ld4(i + 1, 64 + j4);
                const f32x4 cg_ = wg[0] * gp * mp + wg[1] * gc + wg[2] * gn * mn + bg;
                const f32x4 cv_ = wv[0] * vp * mp + wv[1] * vc + wv[2] * vn * mn + bv;
                uint2 o; o.x = cvt_pk_bf16(silu_f(cg_[0]) * cv_[0], silu_f(cg_[1]) * cv_[1]); o.y = cvt_pk_bf16(silu_f(cg_[2]) * cv_[2], silu_f(cg_[3]) * cv_[3]);
                *(uint2*)((bf16_t*)E.out + (size_t)grow * FF + f0) = o;
            }
        }
    } else {
#pragma unroll
        for (int mi = 0; mi < 4; ++mi) {
            const int row = arow_base + wm * 64 + mi * 16 + lr;
#pragma unroll
            for (int ni = 0; ni < 4; ++ni) {
                const int col = n0 + wn * 64 + ni * 16 + quad * 4;
                if (EPI == EPI_F32) *(f32x4*)((float*)E.out + (size_t)row * E.ldc + col) = acc[mi][ni];
                else if (col < E.ncols) { uint2 o; o.x = cvt_pk_bf16(acc[mi][ni][0], acc[mi][ni][1]); o.y = cvt_pk_bf16(acc[mi][ni][2], acc[mi][ni][3]);
                    *(uint2*)((bf16_t*)E.out + (size_t)row * E.ldc + col) = o; }
            }
        }
    }
}
template <int EPI>
__device__ void gemm_phase(const bf16_t* A, int lda, int M, const bf16_t* Bt, int K, int ntn, void* out, int ldc, int ncols, char* lds) {
    const int ntm = M / 128, nt = ntm * ntn;
    EpiArgs E{}; E.out = out; E.ldc = ldc; E.ncols = ncols;
    if ((ntm & 7) == 0 && (gridDim.x & 7) == 0) {
        const int xcd = blockIdx.x & 7, lb = blockIdx.x >> 3, nlb = gridDim.x >> 3, per = (ntm >> 3) * ntn;
        const int mloc = ntm >> 3, nig = 8 * ntn;
        for (int q = lb; q < per; q += nlb) { const int gid = q / nig, fm = gid * 8, gsz = min(mloc - fm, 8), rr = q % nig; const int tm = (fm + rr % gsz) * 8 + xcd, tn = rr / gsz;
            gemm_tile<EPI>(A, lda, tm * 128, 0, M, Bt, K, tn * 128, E, lds); }
        return;
    }
    for (int t = blockIdx.x; t < nt; t += gridDim.x) {
        const int tm = t / ntn, tn = t % ntn;
        gemm_tile<EPI>(A, lda, tm * 128, 0, M, Bt, K, tn * 128, E, lds);
    }
}

__device__ __forceinline__ int swz4(int r) { return (0x78 >> (((r >> 2) & 3) * 2)) & 3; }
__device__ __forceinline__ void ffnup_tile256(const bf16_t* __restrict__ A, int arow_base, int arow_lo, int arow_hi, const bf16_t* __restrict__ Bt, int n0, const EpiArgs& E, int tn, char* lds) {
    const int tid = opaque_tid(), wid = __builtin_amdgcn_readfirstlane(tid >> 6), lane = tid & 63, wm = wid >> 1, wn = wid & 1, lr = lane & 15, quad = lane >> 4;
    constexpr int K = D, STG = 24576;
    unsigned aofs[2], bofs[4];
#pragma unroll
    for (int i = 0; i < 2; ++i) { const int rl = (i * 4 + wid) * 16 + (lane >> 2); const int c = (lane & 3) ^ swz4(rl);
        int r = arow_base + rl; r = r < arow_lo ? arow_lo : (r >= arow_hi ? arow_hi - 1 : r);
        aofs[i] = (unsigned)r * K + c * 8; }
#pragma unroll
    for (int i = 0; i < 4; ++i) { const int rl = (i * 4 + wid) * 16 + (lane >> 2); const int c = (lane & 3) ^ swz4(rl);
        bofs[i] = (unsigned)(n0 + rl) * K + c * 8; }
    LAS char* l3 = (LAS char*)lds;
    auto stage = [&](int kt, int buf) {
#pragma unroll
        for (int i = 0; i < 2; ++i) __builtin_amdgcn_global_load_lds((const unsigned*)(A + aofs[i] + kt * 32), (LAS unsigned*)(l3 + buf * STG + (i * 4 + wid) * 1024), 16, 0, 0);
#pragma unroll
        for (int i = 0; i < 4; ++i) __builtin_amdgcn_global_load_lds((const unsigned*)(Bt + bofs[i] + kt * 32), (LAS unsigned*)(l3 + buf * STG + 8192 + (i * 4 + wid) * 1024), 16, 0, 0);
    };
    f32x4 acc[4][8];
#pragma unroll
    for (int mi = 0; mi < 4; ++mi)
#pragma unroll
        for (int ni = 0; ni < 8; ++ni) acc[mi][ni] = (f32x4){0.f, 0.f, 0.f, 0.f};
    const int ra = wm * 64 + lr, rb = wn * 128 + lr;
    const int aoff0 = ra * 64 + ((quad ^ swz4(ra)) * 16), boff0 = 8192 + rb * 64 + ((quad ^ swz4(rb)) * 16);
    constexpr int nk = K >> 5;
    __syncthreads();
    stage(0, 0);
    for (int kt = 0; kt < nk; ++kt) {
        asm volatile("s_waitcnt vmcnt(0)" ::: "memory");
        __syncthreads();
        if (kt + 1 < nk) stage(kt + 1, (kt + 1) & 1);
        const char* Sb = lds + (kt & 1) * STG;
        bf16x8 af[4];
#pragma unroll
        for (int mi = 0; mi < 4; ++mi) af[mi] = *(const bf16x8*)(Sb + aoff0 + mi * 1024);
        __builtin_amdgcn_s_setprio(1);
#pragma unroll
        for (int nh = 0; nh < 4; ++nh) {
            bf16x8 bfr[2];
#pragma unroll
            for (int q = 0; q < 2; ++q) bfr[q] = *(const bf16x8*)(Sb + boff0 + (nh * 2 + q) * 1024);
#pragma unroll
            for (int mi = 0; mi < 4; ++mi)
#pragma unroll
                for (int q = 0; q < 2; ++q) acc[mi][nh * 2 + q] = __builtin_amdgcn_mfma_f32_16x16x32_bf16(bfr[q], af[mi], acc[mi][nh * 2 + q], 0, 0, 0);
        }
        __builtin_amdgcn_s_setprio(0);
    }
    bf16_t* U = (bf16_t*)lds;
    auto ld4 = [&](int r, int c) { const uint2 u = *(const uint2*)(U + r * 136 + c);
        return (f32x4){__uint_as_float(u.x << 16), __uint_as_float(u.x & 0xffff0000u), __uint_as_float(u.y << 16), __uint_as_float(u.y & 0xffff0000u)}; };
#pragma unroll
    for (int h = 0; h < 2; ++h) {
        const int j4 = (tid & 15) * 4; const int f0 = (2 * tn + h) * 64 + j4;
        f32x4 wg[3], wv[3];
#pragma unroll
        for (int kk = 0; kk < 3; ++kk) { wg[kk] = *(const f32x4*)(E.cw + kk * FF2 + f0); wv[kk] = *(const f32x4*)(E.cw + kk * FF2 + FF + f0); }
        const f32x4 bg = *(const f32x4*)(E.cb + f0), bv = *(const f32x4*)(E.cb + FF + f0);
        __syncthreads();
        if (wn == h) {
#pragma unroll
            for (int mi = 0; mi < 4; ++mi)
#pragma unroll
                for (int ni = 0; ni < 8; ++ni) { uint2 o; o.x = cvt_pk_bf16(acc[mi][ni][0], acc[mi][ni][1]); o.y = cvt_pk_bf16(acc[mi][ni][2], acc[mi][ni][3]);
                    *(uint2*)(U + (wm * 64 + mi * 16 + lr) * 136 + ni * 16 + quad * 4) = o; }
        }
        __syncthreads();
#pragma unroll
        for (int rr = 0; rr < 8; ++rr) {
            const int i = (tid >> 4) + 16 * rr; const int grow = arow_base + i;
            if (i >= 1 && i <= 126 && grow >= E.out_lo && grow < E.out_hi) {
                const float mp = (grow - 1 >= E.seq_lo) ? 1.f : 0.f, mn = (grow + 1 < E.seq_hi) ? 1.f : 0.f;
                const f32x4 gp = ld4(i - 1, j4), gc = ld4(i, j4), gn = ld4(i + 1, j4);
                const f32x4 vp = ld4(i - 1, 64 + j4), vc = ld4(i, 64 + j4), vn = ld4(i + 1, 64 + j4);
                const f32x4 cg_ = wg[0] * gp * mp + wg[1] * gc + wg[2] * gn * mn + bg;
                const f32x4 cv_ = wv[0] * vp * mp + wv[1] * vc + wv[2] * vn * mn + bv;
                uint2 o; o.x = cvt_pk_bf16(silu_f(cg_[0]) * cv_[0], silu_f(cg_[1]) * cv_[1]); o.y = cvt_pk_bf16(silu_f(cg_[2]) * cv_[2], silu_f(cg_[3]) * cv_[3]);
                *(uint2*)((bf16_t*)E.out + (size_t)grow * FF + f0) = o;
            }
        }
    }
}

__device__ void ffnup_phase(const Params& P, int layer, bool with_ctx, char* lds) {
    const int ntn = FF2 / 256;
    const int ntm = 8 * 17 + (with_ctx ? 8 * 3 : 0);
    const int nt = ntm * ntn;
    EpiArgs E{}; E.out = P.p; E.cw = P.ffn_conv_w + (size_t)layer * 3 * FF2; E.cb = P.ffn_conv_b + (size_t)layer * FF2;
    const bool xcdord = ((ntm & 7) == 0) && ((gridDim.x & 7) == 0);
    const int xcd = blockIdx.x & 7, lb = blockIdx.x >> 3, nlb = gridDim.x >> 3, per = (ntm >> 3) * ntn;
    for (int t = xcdord ? lb : blockIdx.x; t < (xcdord ? per : nt); t += (xcdord ? nlb : gridDim.x)) {
        int tm, tn;
        if (xcdord) { const int mloc = ntm >> 3, nig = 8 * ntn, gid = t / nig, fm = gid * 8, gsz = min(mloc - fm, 8), rr = t % nig; tm = (fm + rr % gsz) * 8 + xcd; tn = rr / gsz; }
        else { tm = t / ntn; tn = t % ntn; }
        int s0, L, j;
        if (tm < 136) { s0 = (tm / 17) * SEQ; L = SEQ; j = tm % 17; } else { const int q = tm - 136; s0 = ML + (q / 3) * CTX; L = CTX; j = q % 3; }
        E.seq_lo = s0; E.seq_hi = s0 + L; E.out_lo = s0 + 126 * j; E.out_hi = min(s0 + 126 * j + 126, s0 + L); E.nblk = tn;
        ffnup_tile256(P.hm, s0 + 126 * j - 1, s0, s0 + L, P.w_upT, tn * 256, E, tn, lds);
    }
}

constexpr int VT_ITEMS = 2 * 8 * 2 * 36;
__device__ void vt_item(const Params& P, int it, char* lds) {
    const int tid = opaque_tid();
    const int pt = it % 36, kvh = (it / 36) & 1, b = (it / 72) & 7, type = it / 576;
    const int row0 = (pt < 4) ? (ML + b * CTX + pt * 64) : (b * SEQ + (pt - 4) * 64);
    const int vcol = (type ? P_WV : P_AV) + kvh * 64;
    bf16_t* T = (bf16_t*)lds;
    { const int pos = tid >> 2, seg = (tid & 3) * 16;
      const uint4* src = (const uint4*)(P.p + (size_t)(row0 + pos) * INW + vcol + seg);
      const uint4 a = src[0], c = src[1];
      *(uint4*)(T + pos * 72 + seg) = a; *(uint4*)(T + pos * 72 + seg + 8) = c; }
    __syncthreads();
    { const int dim = tid >> 2, ps = (tid & 3) * 16;
      unsigned w[8];
#pragma unroll
      for (int q = 0; q < 8; ++q) w[q] = (unsigned)T[(ps + 2 * q) * 72 + dim] | ((unsigned)T[(ps + 2 * q + 1) * 72 + dim] << 16);
      uint4* dst = (uint4*)(P.vt + ((size_t)((type * 8 + b) * 2 + kvh) * 64 + dim) * VT_LD + pt * 64 + ps);
      dst[0] = make_uint4(w[0], w[1], w[2], w[3]); dst[1] = make_uint4(w[4], w[5], w[6], w[7]); }
    __syncthreads();
}
__device__ void qkprep_rows(const Params& P, int layer, int row, int lane) {
    const bool lat = row < ML;
    const int t = lat ? (row & (SEQ - 1)) : 0;
    const int i = lane & 31;
    float cs = 1.f, sn = 0.f;
    if (lat) { const int fi = i & 15; const float invf = exp2f(-(float)fi * (13.287712379549449f / 16.f)); const float pos = (i < 16) ? (float)(t >> 6) : (float)(t & 63);
        const float ang = pos * invf; cs = __cosf(ang); sn = __sinf(ang); }
    bf16_t* pr = P.p + (size_t)row * INW;
    const float qs = 0.125f * 1.4426950408889634f;
#pragma unroll
    for (int it = 0; it < 6; ++it) {
        const int slot = it * 2 + (lane >> 5);
        int col; float scl = 1.f; const float* gain = nullptr;
        if (slot < 4) { col = P_AQ + slot * 64; gain = P.attn_q_norm + layer * 64; scl = qs; }
        else if (slot < 6) { col = P_AK + (slot - 4) * 64; gain = P.attn_k_norm + layer * 64; }
        else if (slot < 10) { col = P_WQ + (slot - 6) * 64; scl = qs; }
        else col = P_WK + (slot - 10) * 64;
        unsigned* ptr = (unsigned*)(pr + col + 2 * i);
        const unsigned u = *ptr;
        float x0 = __uint_as_float(u << 16), x1 = __uint_as_float(u & 0xffff0000u);
        if (slot < 6) {
            float ss = x0 * x0 + x1 * x1;
#pragma unroll
            for (int o = 16; o >= 1; o >>= 1) ss += __shfl_xor(ss, o);
            const float rstd = rsqrtf(ss * (1.f / 64.f) + EPS);
            x0 = x0 * rstd * gain[2 * i]; x1 = x1 * rstd * gain[2 * i + 1];
        }
        const float y0 = (x0 * cs - x1 * sn) * scl, y1 = (x0 * sn + x1 * cs) * scl;
        *ptr = cvt_pk_bf16(y0, y1);
    }
}


__device__ __forceinline__ void gdnprep_row(const Params& P, int layer, int row, int lane, const float (&cwr)[24]) {
    const bool lat = row < ML; const int s0 = lat ? (row & ~(SEQ - 1)) : (ML + ((row - ML) & ~(CTX - 1))), L = lat ? SEQ : CTX, t = row - s0;
    const int seg = lane >> 5, c0 = (lane & 31) * 8, pcol = (seg ? P_GK : P_GQ) + c0;
    float x0[8], x1[8], x2[8];
    const u32x4 z4 = {0u, 0u, 0u, 0u};
    unpack8(t > 0 ? *(const u32x4*)(P.p + (size_t)(row - 1) * INW + pcol) : z4, x0);
    unpack8(*(const u32x4*)(P.p + (size_t)row * INW + pcol), x1);
    unpack8(t + 1 < L ? *(const u32x4*)(P.p + (size_t)(row + 1) * INW + pcol) : z4, x2);
    float y[8], ss = 0.f;
#pragma unroll
    for (int q = 0; q < 8; ++q) { const float v = silu_f(cwr[q] * x0[q] + cwr[8 + q] * x1[q] + cwr[16 + q] * x2[q]); y[q] = v; ss += v * v; }
    ss = red8(ss);
    const float sc = rsqrtf(ss + EPS) * (seg == 0 ? 0.125f : 1.f);
    const u32x4 pk = {cvt_pk_bf16(y[0] * sc, y[1] * sc), cvt_pk_bf16(y[2] * sc, y[3] * sc), cvt_pk_bf16(y[4] * sc, y[5] * sc), cvt_pk_bf16(y[6] * sc, y[7] * sc)};
    *(u32x4*)(P.gqk + (size_t)row * 512 + lane * 8) = pk;
}

__device__ void attn_item(const Params& P, int layer, int type, int b, int kvh, int qt, bool is_ctx, char* lds) {
    const int tid = opaque_tid(), w = tid >> 6, lane = tid & 63, lr = lane & 15, quad = lane >> 4;
    const bf16_t* pp = P.p;
    const int qcol = (type ? P_WQ : P_AQ) + kvh * 128, kcol = (type ? P_WK : P_AK) + kvh * 64;
    const int qrow0 = is_ctx ? (ML + b * CTX + qt * 64) : (b * SEQ + qt * 64);
    const int myq = qrow0 + w * 16 + lr;
    bf16x8 qf[2][2];
#pragma unroll
    for (int g = 0; g < 2; ++g)
#pragma unroll
        for (int ks = 0; ks < 2; ++ks) qf[g][ks] = *(const bf16x8*)(pp + (size_t)myq * INW + qcol + g * 64 + ks * 32 + quad * 8);
    int lt0 = 0, nlat = 0;
    if (!is_ctx) { if (type == 0) { lt0 = 0; nlat = 32; } else { lt0 = max(0, qt - 2); nlat = min(31, qt + 2) - lt0 + 1; } }
    const int nt = 4 + nlat;
    const bf16_t* vbase = P.vt + (size_t)((type * 8 + b) * 2 + kvh) * 64 * VT_LD;
    char* Ks = lds; char* Vs = lds + 8192;
    const int sr = tid >> 3, sc = tid & 7;
    const int swr = sr * 128 + ((sc ^ (sr & 7)) * 16);
    float m[2], l[2]; f32x4 o[2][4];
#pragma unroll
    for (int g = 0; g < 2; ++g) {
        if (type == 1) { m[g] = P.swa_sink[layer * 4 + kvh * 2 + g] * 1.4426950408889634f; l[g] = (quad == 0) ? 1.f : 0.f; } else { m[g] = -1e30f; l[g] = 0.f; }
#pragma unroll
        for (int db = 0; db < 4; ++db) o[g][db] = (f32x4){0.f, 0.f, 0.f, 0.f};
    }
    u32x4 rk[2], rv[2];
    auto issue = [&](int ti) {
        const int krow0 = (ti < 4) ? (ML + b * CTX + ti * 64) : (b * SEQ + (lt0 + ti - 4) * 64);
        const int pos0 = (ti < 4) ? ti * 64 : 256 + (lt0 + ti - 4) * 64;
#pragma unroll
        for (int i = 0; i < 2; ++i) { rk[i] = *(const u32x4*)(pp + (size_t)(krow0 + sr + 32 * i) * INW + kcol + sc * 8);
            rv[i] = *(const u32x4*)(vbase + (size_t)(sr + 32 * i) * VT_LD + pos0 + sc * 8); }
    };
    issue(0);
    const int qp = qt * 64 + w * 16 + lr;
    for (int ti = 0; ti < nt; ++ti) {
        __syncthreads();
#pragma unroll
        for (int i = 0; i < 2; ++i) { *(u32x4*)(Ks + swr + i * 4096) = rk[i]; *(u32x4*)(Vs + swr + i * 4096) = rv[i]; }
        __syncthreads();
        if (ti + 1 < nt) issue(ti + 1);
        f32x4 s[2][4];
#pragma unroll
        for (int g = 0; g < 2; ++g)
#pragma unroll
            for (int kb = 0; kb < 4; ++kb) s[g][kb] = (f32x4){0.f, 0.f, 0.f, 0.f};
#pragma unroll
        for (int ks = 0; ks < 2; ++ks)
#pragma unroll
            for (int kb = 0; kb < 4; ++kb) { const int r = kb * 16 + lr; const int ch = ks * 4 + quad;
                const bf16x8 kf = *(const bf16x8*)(Ks + r * 128 + ((ch ^ (r & 7)) * 16));
#pragma unroll
                for (int g = 0; g < 2; ++g) s[g][kb] = __builtin_amdgcn_mfma_f32_16x16x32_bf16(kf, qf[g][ks], s[g][kb], 0, 0, 0); }
        if (type == 1 && ti >= 4) {
            const int kp0 = (lt0 + ti - 4) * 64 + quad * 4;
#pragma unroll
            for (int kb = 0; kb < 4; ++kb)
#pragma unroll
                for (int j = 0; j < 4; ++j) { const int dlt = qp - (kp0 + kb * 16 + j); const bool ok = (dlt <= 128) && (dlt >= -128);
#pragma unroll
                    for (int g = 0; g < 2; ++g) s[g][kb][j] = ok ? s[g][kb][j] : -1e30f; }
        }
        bf16x8 pf[2][2];
#pragma unroll
        for (int g = 0; g < 2; ++g) {
            float mx = -1e30f;
#pragma unroll
            for (int kb = 0; kb < 4; ++kb) mx = fmaxf(mx, fmaxf(fmaxf(s[g][kb][0], s[g][kb][1]), fmaxf(s[g][kb][2], s[g][kb][3])));
            mx = fmaxf(mx, __shfl_xor(mx, 16)); mx = fmaxf(mx, __shfl_xor(mx, 32));
            const float mn = fmaxf(m[g], mx); const float alpha = exp2f(m[g] - mn); m[g] = mn;
            float ps = 0.f;
#pragma unroll
            for (int kb = 0; kb < 4; ++kb)
#pragma unroll
                for (int j = 0; j < 4; ++j) { const float e = exp2f(s[g][kb][j] - mn); s[g][kb][j] = e; ps += e; }
            l[g] = l[g] * alpha + ps;
#pragma unroll
            for (int db = 0; db < 4; ++db) o[g][db] *= alpha;
#pragma unroll
            for (int ks = 0; ks < 2; ++ks) {
                u32x4 pk;
                pk[0] = cvt_pk_bf16(s[g][2 * ks][0], s[g][2 * ks][1]); pk[1] = cvt_pk_bf16(s[g][2 * ks][2], s[g][2 * ks][3]);
                pk[2] = cvt_pk_bf16(s[g][2 * ks + 1][0], s[g][2 * ks + 1][1]); pk[3] = cvt_pk_bf16(s[g][2 * ks + 1][2], s[g][2 * ks + 1][3]);
                pf[g][ks] = __builtin_bit_cast(bf16x8, pk);
            }
        }
#pragma unroll
        for (int ks = 0; ks < 2; ++ks)
#pragma unroll
            for (int db = 0; db < 4; ++db) { const int dim = db * 16 + lr; const int c1 = ks * 4 + (quad >> 1), c2 = c1 + 2;
                const uint2 h0 = *(const uint2*)(Vs + dim * 128 + ((c1 ^ (dim & 7)) * 16) + (quad & 1) * 8);
                const uint2 h1 = *(const uint2*)(Vs + dim * 128 + ((c2 ^ (dim & 7)) * 16) + (quad & 1) * 8);
                const bf16x8 vfv = __builtin_bit_cast(bf16x8, (u32x4){h0.x, h0.y, h1.x, h1.y});
#pragma unroll
                for (int g = 0; g < 2; ++g) o[g][db] = __builtin_amdgcn_mfma_f32_16x16x32_bf16(vfv, pf[g][ks], o[g][db], 0, 0, 0); }
    }
    const int mixcol = (type ? 512 : 256) + kvh * 128;
#pragma unroll
    for (int g = 0; g < 2; ++g) {
        float lt = l[g]; lt += __shfl_xor(lt, 16); lt += __shfl_xor(lt, 32);
        const float inv = 1.f / lt;
#pragma unroll
        for (int db = 0; db < 4; ++db) { uint2 ov; ov.x = cvt_pk_bf16(o[g][db][0] * inv, o[g][db][1] * inv); ov.y = cvt_pk_bf16(o[g][db][2] * inv, o[g][db][3] * inv);
            *(uint2*)(P.hm + (size_t)myq * D + mixcol + g * 64 + db * 16 + quad * 4) = ov; }
    }
    __syncthreads();
}

constexpr int TCH = 32;

typedef short bf16x4 __attribute__((ext_vector_type(4)));
typedef unsigned u32x2 __attribute__((ext_vector_type(2)));
__device__ __forceinline__ bf16x4 pack4(f32x4 v) { const u32x2 u = {cvt_pk_bf16(v[0], v[1]), cvt_pk_bf16(v[2], v[3])}; return __builtin_bit_cast(bf16x4, u); }
__device__ __forceinline__ f32x4 unpack4(u32x2 u) { return (f32x4){__uint_as_float(u[0] << 16), __uint_as_float(u[0] & 0xffff0000u), __uint_as_float(u[1] << 16), __uint_as_float(u[1] & 0xffff0000u)}; }
__device__ void gdn_chunked(const Params& P, int layer, int item, char* lds) {
    __builtin_amdgcn_s_setprio(3);
    const int tid0 = opaque_tid(), w = __builtin_amdgcn_readfirstlane(tid0 >> 6);
    const int dir = item & 1, h = (item >> 1) & 3, b = item >> 3;
    constexpr int TSE = 64 * 72;
    bf16_t* St = (bf16_t*)lds;
    bf16_t* Kh = St + TSE;
    bf16_t* Qh = Kh + TSE;
    bf16_t* Vt = Qh + TSE;
    bf16_t* Kdt = Vt + TSE;
    bf16_t* nM = Kdt + TSE;
    bf16_t* At = nM + TSE;
    bf16_t* raw = nM;
    float* cw = (float*)(lds + 59136);
    float* gsc = (float*)(lds + 64512);
    const float neg_ea = -__expf(P.gdn_a_log[layer * 8 + dir * 4 + h]);
    const float dtb = P.gdn_dt_bias[layer * 8 + dir * 4 + h];
    f32x4 Sreg[4];
#pragma unroll
    for (int nb = 0; nb < 4; ++nb) Sreg[nb] = (f32x4){0.f, 0.f, 0.f, 0.f};
    for (int i = tid0; i < TSE / 2; i += 256) ((unsigned*)St)[i] = 0u;
    u32x4 preqk[4], prev[3]; unsigned pab = 0;
    int tid = tid0;
    const float cwreg = (tid0 < 192) ? P.gdn_conv_w[(size_t)layer * 3 * 768 + (tid0 >> 6) * 768 + 512 + h * 64 + (tid0 & 63)] : 0.f;
    bf16_t* rawv = nM;
    float* cwv = (float*)(lds + 59136);
    auto chunk_info = [&](int ci, int& sbase, int& L, int& t0c, bool& isctx) {
        isctx = ci < 4; const int n = isctx ? 4 : 32; int cj = isctx ? ci : ci - 4; if (dir) cj = n - 1 - cj;
        sbase = isctx ? (ML + b * CTX) : (b * SEQ); L = isctx ? CTX : SEQ; t0c = cj * 64;
    };
    auto issue = [&](int ci) {
        int sbase, L, t0c; bool isctx; chunk_info(ci, sbase, L, t0c, isctx);
#pragma unroll
        for (int i = 0; i < 4; ++i) { const int idx = tid + 256 * i; const int row = idx >> 4, part = idx & 15; const int trow = t0c + (dir ? 63 - row : row);
            const int col = (part < 8) ? h * 64 + part * 8 : 256 + h * 64 + (part - 8) * 8;
            preqk[i] = *(const u32x4*)(P.gqk + (size_t)(sbase + trow) * 512 + col); }
#pragma unroll
        for (int i = 0; i < 3; ++i) { const int idx = tid + 256 * i; const int rr = idx >> 3, ch = idx & 7; const int tr = t0c - 1 + rr;
            if (idx < 528 && tr >= 0 && tr < L) prev[i] = *(const u32x4*)(P.p + (size_t)(sbase + tr) * INW + P_GV + h * 64 + ch * 8); else prev[i] = (u32x4){0u, 0u, 0u, 0u}; }
        if (tid < 64) { const bf16_t* pr = P.p + (size_t)(sbase + t0c + tid) * INW; pab = (unsigned)pr[P_BETA + dir * 4 + h] | ((unsigned)pr[P_A + dir * 4 + h] << 16); }
    };
    issue(0);
    for (int ci = 0; ci < 36; ++ci) {
        asm volatile("" : "+v"(tid));
        const int lane = tid & 63, lr = lane & 15, quad = lane >> 4;
        int sbase = 0, L = 0, t0c = 0; bool isctx = false;
        chunk_info(ci, sbase, L, t0c, isctx);
        __syncthreads();
#pragma unroll
        for (int i = 0; i < 4; ++i) { const int idx = tid + 256 * i; const int row = idx >> 4, part = idx & 15;
            if (part < 8) *(u32x4*)(Qh + row * 72 + part * 8) = preqk[i]; else *(u32x4*)(Kh + row * 72 + (part - 8) * 8) = preqk[i]; }
#pragma unroll
        for (int i = 0; i < 3; ++i) { const int idx = tid + 256 * i; if (idx < 528) *(u32x4*)(rawv + idx * 8) = prev[i]; }
        if (tid < 192) cwv[tid] = cwreg;
        if (tid < 64) { const int i = dir ? 63 - tid : tid;
            const float braw = __uint_as_float(pab << 16), araw = __uint_as_float(pab & 0xffff0000u);
            const float av = araw + dtb; const float sp = (av > 20.f) ? av : __logf(1.f + __expf(av));
            float g = neg_ea * sp; gsc[i] = g; gsc[128 + i] = sigmoid_f(braw);
#pragma unroll
            for (int o = 1; o < 64; o <<= 1) { const float t = dir ? __shfl_down(g, o) : __shfl_up(g, o); if (dir ? (tid + o < 64) : (tid >= o)) g += t; }
            gsc[64 + i] = g; gsc[192 + i] = __expf(g); }
        __syncthreads();
        if (ci + 1 < 36) issue(ci + 1);
        { const int rg = tid >> 2, c0 = (tid & 3) * 16, i = dir ? 63 - rg : rg;
#pragma unroll
          for (int hf = 0; hf < 2; ++hf) { float x0[8], x1[8], x2[8], yv[8];
              unpack8(*(const u32x4*)(rawv + rg * 64 + c0 + hf * 8), x0); unpack8(*(const u32x4*)(rawv + (rg + 1) * 64 + c0 + hf * 8), x1); unpack8(*(const u32x4*)(rawv + (rg + 2) * 64 + c0 + hf * 8), x2);
#pragma unroll
              for (int q = 0; q < 8; ++q) { const int c = c0 + hf * 8 + q; yv[q] = silu_f(cwv[c] * x0[q] + cwv[64 + c] * x1[q] + cwv[128 + c] * x2[q]); }
              *(u32x4*)(Vt + i * 72 + c0 + hf * 8) = (u32x4){cvt_pk_bf16(yv[0], yv[1]), cvt_pk_bf16(yv[2], yv[3]), cvt_pk_bf16(yv[4], yv[5]), cvt_pk_bf16(yv[6], yv[7])}; } }
        __syncthreads();
        const float gc_last = gsc[64 + 63], g_last = gsc[192 + 63];
        { const int i = tid >> 2, part = tid & 3; const float sc = __expf(gc_last - gsc[64 + i]);
          float kv[16]; unpack8(*(const u32x4*)(Kh + i * 72 + part * 16), kv); unpack8(*(const u32x4*)(Kh + i * 72 + part * 16 + 8), kv + 8);
#pragma unroll
          for (int q = 0; q < 16; ++q) Kdt[(part * 16 + q) * 72 + i] = f2bf(kv[q] * sc); }
        {
            f32x4 kk[4], qk[4];
#pragma unroll
            for (int nb = 0; nb < 4; ++nb) { kk[nb] = (f32x4){0.f, 0.f, 0.f, 0.f}; qk[nb] = (f32x4){0.f, 0.f, 0.f, 0.f}; }
#pragma unroll
            for (int ks = 0; ks < 2; ++ks) {
                const bf16x8 ak = *(const bf16x8*)(Kh + (16 * w + lr) * 72 + ks * 32 + quad * 8), aq = *(const bf16x8*)(Qh + (16 * w + lr) * 72 + ks * 32 + quad * 8);
#pragma unroll
                for (int nb = 0; nb < 4; ++nb) if (nb <= w) { const bf16x8 bj = *(const bf16x8*)(Kh + (16 * nb + lr) * 72 + ks * 32 + quad * 8);
                    kk[nb] = __builtin_amdgcn_mfma_f32_16x16x32_bf16(bj, ak, kk[nb], 0, 0, 0); qk[nb] = __builtin_amdgcn_mfma_f32_16x16x32_bf16(bj, aq, qk[nb], 0, 0, 0); }
            }
            const int i = 16 * w + lr; const float gci = gsc[64 + i], bi = gsc[128 + i];
#pragma unroll
            for (int nb = 0; nb < 4; ++nb) { f32x4 mv, av;
#pragma unroll
                for (int jj = 0; jj < 4; ++jj) { const int j = 16 * nb + quad * 4 + jj; const float dec = (i >= j) ? __expf(gci - gsc[64 + j]) : 0.f;
                    mv[jj] = (i > j) ? -bi * kk[nb][jj] * dec : 0.f; av[jj] = qk[nb][jj] * dec; }
                *(u32x2*)(nM + i * 72 + 16 * nb + quad * 4) = (u32x2){cvt_pk_bf16(mv[0], mv[1]), cvt_pk_bf16(mv[2], mv[3])};
                *(u32x2*)(At + i * 72 + 16 * nb + quad * 4) = (u32x2){cvt_pk_bf16(av[0], av[1]), cvt_pk_bf16(av[2], av[3])}; }
        }
        __syncthreads();
        {
            const bf16x4 nf = __builtin_bit_cast(bf16x4, *(const u32x2*)(nM + (16 * w + lr) * 72 + 16 * w + quad * 4));
            f32x4 pw, sum;
#pragma unroll
            for (int jj = 0; jj < 4; ++jj) { pw[jj] = bf2f(nM[(16 * w + quad * 4 + jj) * 72 + 16 * w + lr]); sum[jj] = pw[jj] + ((quad * 4 + jj == lr) ? 1.f : 0.f); }
#pragma unroll
            for (int k = 2; k < 16; ++k) { pw = __builtin_amdgcn_mfma_f32_16x16x16bf16_1k(nf, pack4(pw), (f32x4){0.f, 0.f, 0.f, 0.f}, 0, 0, 0); sum += pw; }
#pragma unroll
            for (int jj = 0; jj < 4; ++jj) nM[(16 * w + quad * 4 + jj) * 72 + 16 * w + lr] = f2bf(sum[jj]);
        }
        f32x4 X[4][2];
#pragma unroll
        for (int bb = 0; bb < 4; ++bb)
#pragma unroll
            for (int nb = 0; nb < 2; ++nb)
#pragma unroll
                for (int jj = 0; jj < 4; ++jj) { const int i = 16 * bb + quad * 4 + jj; const int n = 32 * (w & 1) + 16 * nb + lr;
                    X[bb][nb][jj] = (w < 2) ? gsc[128 + i] * bf2f(Vt[i * 72 + n]) : gsc[128 + i] * gsc[192 + i] * bf2f(Kh[i * 72 + n]); }
        __syncthreads();
        {
            bf16x4 Xb[4][2];
#pragma unroll
            for (int bb = 0; bb < 4; ++bb) {
#pragma unroll
                for (int bp = 0; bp < bb; ++bp) { const bf16x4 lf = __builtin_bit_cast(bf16x4, *(const u32x2*)(nM + (16 * bb + lr) * 72 + 16 * bp + quad * 4));
#pragma unroll
                    for (int nb = 0; nb < 2; ++nb) X[bb][nb] = __builtin_amdgcn_mfma_f32_16x16x16bf16_1k(lf, Xb[bp][nb], X[bb][nb], 0, 0, 0); }
                const bf16x4 df = __builtin_bit_cast(bf16x4, *(const u32x2*)(nM + (16 * bb + lr) * 72 + 16 * bb + quad * 4));
#pragma unroll
                for (int nb = 0; nb < 2; ++nb) { const bf16x4 zb = pack4(X[bb][nb]);
                    X[bb][nb] = __builtin_amdgcn_mfma_f32_16x16x16bf16_1k(df, zb, (f32x4){0.f, 0.f, 0.f, 0.f}, 0, 0, 0); Xb[bb][nb] = pack4(X[bb][nb]); }
            }
#pragma unroll
            for (int bb = 0; bb < 4; ++bb)
#pragma unroll
                for (int nb = 0; nb < 2; ++nb) { const int n = 32 * (w & 1) + 16 * nb + lr, i0 = 16 * bb + quad * 4;
                    if (w < 2) *(u32x2*)(Vt + n * 72 + i0) = __builtin_bit_cast(u32x2, Xb[bb][nb]);
                    else {
#pragma unroll
                        for (int jj = 0; jj < 4; ++jj) Kh[(i0 + jj) * 72 + n] = (bf16_t)Xb[bb][nb][jj]; } }
        }
        __syncthreads();
        {
            f32x4 acc[4];
#pragma unroll
            for (int nb = 0; nb < 4; ++nb) acc[nb] = (f32x4){0.f, 0.f, 0.f, 0.f};
#pragma unroll
            for (int ks = 0; ks < 2; ++ks) { const bf16x8 se = *(const bf16x8*)(St + (16 * w + lr) * 72 + ks * 32 + quad * 8);
#pragma unroll
                for (int nb = 0; nb < 4; ++nb) { const bf16x8 wi = *(const bf16x8*)(Kh + (16 * nb + lr) * 72 + ks * 32 + quad * 8);
                    acc[nb] = __builtin_amdgcn_mfma_f32_16x16x32_bf16(wi, se, acc[nb], 0, 0, 0); } }
            const int e = 16 * w + lr;
            f32x4 vn[4];
#pragma unroll
            for (int nb = 0; nb < 4; ++nb) vn[nb] = unpack4(*(const u32x2*)(Vt + e * 72 + 16 * nb + quad * 4)) - acc[nb];
            __syncthreads();
#pragma unroll
            for (int nb = 0; nb < 4; ++nb) *(u32x2*)(nM + e * 72 + 16 * nb + quad * 4) = (u32x2){cvt_pk_bf16(vn[nb][0], vn[nb][1]), cvt_pk_bf16(vn[nb][2], vn[nb][3])};
        }
        __syncthreads();
        {
            f32x4 o1[4], o2[4], sa[4];
#pragma unroll
            for (int nb = 0; nb < 4; ++nb) { o1[nb] = (f32x4){0.f, 0.f, 0.f, 0.f}; o2[nb] = (f32x4){0.f, 0.f, 0.f, 0.f}; sa[nb] = (f32x4){0.f, 0.f, 0.f, 0.f}; }
#pragma unroll
            for (int ks = 0; ks < 2; ++ks) {
                const bf16x8 bq = *(const bf16x8*)(Qh + (16 * w + lr) * 72 + ks * 32 + quad * 8), ba = *(const bf16x8*)(At + (16 * w + lr) * 72 + ks * 32 + quad * 8);
                const bf16x8 bv = *(const bf16x8*)(nM + (16 * w + lr) * 72 + ks * 32 + quad * 8);
#pragma unroll
                for (int nb = 0; nb < 4; ++nb) {
                    const bf16x8 as_ = *(const bf16x8*)(St + (16 * nb + lr) * 72 + ks * 32 + quad * 8), av = *(const bf16x8*)(nM + (16 * nb + lr) * 72 + ks * 32 + quad * 8);
                    const bf16x8 ak = *(const bf16x8*)(Kdt + (16 * nb + lr) * 72 + ks * 32 + quad * 8);
                    o1[nb] = __builtin_amdgcn_mfma_f32_16x16x32_bf16(as_, bq, o1[nb], 0, 0, 0);
                    o2[nb] = __builtin_amdgcn_mfma_f32_16x16x32_bf16(av, ba, o2[nb], 0, 0, 0);
                    sa[nb] = __builtin_amdgcn_mfma_f32_16x16x32_bf16(ak, bv, sa[nb], 0, 0, 0);
                }
            }
            { const int i = 16 * w + lr; const float eg = gsc[192 + i]; const int t = t0c + (dir ? 63 - i : i);
                bf16_t* orow = P.r2 + ((size_t)(0 * 2 + dir) * MT + sbase + t) * 256 + h * 64;
#pragma unroll
                for (int nb = 0; nb < 4; ++nb) { const f32x4 ov = o1[nb] * eg + o2[nb];
                    *(u32x2*)(orow + 16 * nb + quad * 4) = (u32x2){cvt_pk_bf16(ov[0], ov[1]), cvt_pk_bf16(ov[2], ov[3])}; } }
#pragma unroll
            for (int nb = 0; nb < 4; ++nb) Sreg[nb] = Sreg[nb] * g_last + sa[nb];
            __syncthreads();
            const int e = 16 * w + lr;
#pragma unroll
            for (int nb = 0; nb < 4; ++nb) *(u32x2*)(St + e * 72 + 16 * nb + quad * 4) = (u32x2){cvt_pk_bf16(Sreg[nb][0], Sreg[nb][1]), cvt_pk_bf16(Sreg[nb][2], Sreg[nb][3])};
        }
    }
    __syncthreads();
    __builtin_amdgcn_s_setprio(0);
}

__device__ void hgrn_chunked(const Params& P, int layer, int item, char* lds) {
    const int tid0 = opaque_tid(), w = __builtin_amdgcn_readfirstlane(tid0 >> 6);
    const int dir = item & 1, h = (item >> 1) & 3, b = item >> 3;
    constexpr int TSE = 64 * 72;
    bf16_t* qraw = (bf16_t*)lds;
    bf16_t* zraw = qraw + 4096;
    bf16_t* Qt = zraw + 4096;
    bf16_t* Kt = Qt + TSE;
    bf16_t* Qs = Kt + TSE;
    bf16_t* KdT = Qs + TSE;
    bf16_t* VT = KdT + TSE;
    float* gt = (float*)(VT + TSE);
    bf16_t* Ab = qraw;
    float lb;
    { const int d = tid0 & 63; const float r0 = P.hgrn_lb_raw[(0 * 2 + dir) * 256 + h * 64 + d], r1 = P.hgrn_lb_raw[(1 * 2 + dir) * 256 + h * 64 + d];
      const float mx = fmaxf(r0, r1), e0 = __expf(r0 - mx), e1 = __expf(r1 - mx); lb = (layer == 0) ? 0.f : e1 / (e0 + e1); }
    f32x4 Sreg[4];
#pragma unroll
    for (int nb = 0; nb < 4; ++nb) Sreg[nb] = (f32x4){0.f, 0.f, 0.f, 0.f};
    u32x4 pre[6];
    int tid = tid0;
    auto chunk_info = [&](int ci, int& sbase, int& t0c, bool& isctx) {
        isctx = ci < 4; const int n = isctx ? 4 : 32; int cj = isctx ? ci : ci - 4; if (dir) cj = n - 1 - cj;
        sbase = isctx ? (ML + b * CTX) : (b * SEQ); t0c = cj * 64;
    };
    auto issue = [&](int ci) {
        int sbase, t0c; bool isctx; chunk_info(ci, sbase, t0c, isctx);
#pragma unroll
        for (int i = 0; i < 6; ++i) { const int idx = tid + 256 * i; const int row = idx / 24, rem = idx % 24, seg = rem >> 3, ch = rem & 7;
            const int col = (seg == 0 ? P_HQ : (seg == 1 ? P_HF + dir * 256 : P_HI)) + h * 64 + ch * 8; const int trow = t0c + (dir ? 63 - row : row);
            pre[i] = *(const u32x4*)(P.p + (size_t)(sbase + trow) * INW + col); }
    };
    issue(0);
    for (int ci = 0; ci < 36; ++ci) {
        asm volatile("" : "+v"(tid));
        const int lane = tid & 63, lr = lane & 15, quad = lane >> 4;
        int sbase, t0c; bool isctx; chunk_info(ci, sbase, t0c, isctx);
        __syncthreads();
#pragma unroll
        for (int i = 0; i < 6; ++i) { const int idx = tid + 256 * i; const int row = idx / 24, rem = idx % 24, seg = rem >> 3, ch = rem & 7;
            if (seg == 0) *(u32x4*)(qraw + row * 64 + ch * 8) = pre[i];
            else if (seg == 1) *(u32x4*)(zraw + row * 64 + ch * 8) = pre[i];
            else {
#pragma unroll
                for (int q = 0; q < 4; ++q) { VT[(ch * 8 + 2 * q) * 72 + row] = (bf16_t)(pre[i][q] & 0xffffu); VT[(ch * 8 + 2 * q + 1) * 72 + row] = (bf16_t)(pre[i][q] >> 16); } } }
        __syncthreads();
        if (ci + 1 < 36) issue(ci + 1);
        { const int d = tid & 63, sc = tid >> 6;
          float bcv[16], qv[16], kv[16]; float c = 0.f;
#pragma unroll
          for (int r = 0; r < 16; ++r) { const int i = 16 * sc + r; float z = bf2f(zraw[i * 64 + d]); z = fminf(fmaxf(z, -30.f), 30.f);
              const float ez = __expf(-z), sg = __builtin_amdgcn_rcpf(1.f + ez); const float f = lb + (1.f - lb) * sg;
              c += __logf(f); bcv[r] = c; kv[r] = (1.f - lb) * ez * sg; qv[r] = silu_f(bf2f(qraw[i * 64 + d])); }
          const float m = bcv[7], last = c, em = __expf(m), elm = __expf(last - m);
          float kd[16];
#pragma unroll
          for (int r = 0; r < 16; ++r) { const int i = 16 * sc + r; const float E1 = __expf(bcv[r] - m), E2 = __expf(m - bcv[r]);
              const float q1 = qv[r] * E1, k2 = kv[r] * E2;
              Qt[i * 72 + d] = f2bf(q1); Kt[i * 72 + d] = f2bf(k2); Qs[i * 72 + d] = f2bf(q1 * em); kd[r] = k2 * elm; }
          *(u32x4*)(KdT + d * 72 + 16 * sc) = (u32x4){cvt_pk_bf16(kd[0], kd[1]), cvt_pk_bf16(kd[2], kd[3]), cvt_pk_bf16(kd[4], kd[5]), cvt_pk_bf16(kd[6], kd[7])};
          *(u32x4*)(KdT + d * 72 + 16 * sc + 8) = (u32x4){cvt_pk_bf16(kd[8], kd[9]), cvt_pk_bf16(kd[10], kd[11]), cvt_pk_bf16(kd[12], kd[13]), cvt_pk_bf16(kd[14], kd[15])};
          gt[sc * 64 + d] = __expf(last); }
        __syncthreads();
        { f32x4 a = (f32x4){0.f, 0.f, 0.f, 0.f};
#pragma unroll
          for (int ks = 0; ks < 2; ++ks) { const bf16x8 kj = *(const bf16x8*)(Kt + (16 * w + lr) * 72 + ks * 32 + quad * 8), qi = *(const bf16x8*)(Qt + (16 * w + lr) * 72 + ks * 32 + quad * 8);
              a = __builtin_amdgcn_mfma_f32_16x16x32_bf16(kj, qi, a, 0, 0, 0); }
#pragma unroll
          for (int jj = 0; jj < 4; ++jj) if (quad * 4 + jj > lr) a[jj] = 0.f;
          *(u32x2*)(Ab + (16 * w + lr) * 24 + quad * 4) = (u32x2){cvt_pk_bf16(a[0], a[1]), cvt_pk_bf16(a[2], a[3])}; }
        __syncthreads();
#pragma unroll 1
        for (int sc = 0; sc < 4; ++sc) {
            f32x4 o = (f32x4){0.f, 0.f, 0.f, 0.f};
#pragma unroll
            for (int ks = 0; ks < 2; ++ks) {
                const u32x2 s0 = __builtin_bit_cast(u32x2, pack4(Sreg[2 * ks])), s1 = __builtin_bit_cast(u32x2, pack4(Sreg[2 * ks + 1]));
                const bf16x8 sa = __builtin_bit_cast(bf16x8, (u32x4){s0[0], s0[1], s1[0], s1[1]});
                const u32x2 q0 = *(const u32x2*)(Qs + (16 * sc + lr) * 72 + 32 * ks + 4 * quad), q1 = *(const u32x2*)(Qs + (16 * sc + lr) * 72 + 32 * ks + 16 + 4 * quad);
                const bf16x8 qb = __builtin_bit_cast(bf16x8, (u32x4){q0[0], q0[1], q1[0], q1[1]});
                o = __builtin_amdgcn_mfma_f32_16x16x32_bf16(sa, qb, o, 0, 0, 0);
            }
            const bf16x4 vt = __builtin_bit_cast(bf16x4, *(const u32x2*)(VT + (16 * w + lr) * 72 + 16 * sc + quad * 4));
            const bf16x4 ab = __builtin_bit_cast(bf16x4, *(const u32x2*)(Ab + (16 * sc + lr) * 24 + quad * 4));
            o = __builtin_amdgcn_mfma_f32_16x16x16bf16_1k(vt, ab, o, 0, 0, 0);
            { const int i = 16 * sc + lr; const int t = t0c + (dir ? 63 - i : i);
                *(u32x2*)(P.r2 + ((size_t)(1 * 2 + dir) * MT + sbase + t) * 256 + h * 64 + 16 * w + quad * 4) = (u32x2){cvt_pk_bf16(o[0], o[1]), cvt_pk_bf16(o[2], o[3])}; }
#pragma unroll
            for (int nb = 0; nb < 4; ++nb) {
                const bf16x4 kf = __builtin_bit_cast(bf16x4, *(const u32x2*)(KdT + (16 * nb + lr) * 72 + 16 * sc + quad * 4));
                const f32x4 upd = __builtin_amdgcn_mfma_f32_16x16x16bf16_1k(kf, vt, (f32x4){0.f, 0.f, 0.f, 0.f}, 0, 0, 0);
                const f32x4 gv = *(const f32x4*)(gt + sc * 64 + 16 * nb + quad * 4);
                Sreg[nb] = Sreg[nb] * gv + upd;
            }
        }
    }
    __syncthreads();
}

__device__ void scanfin_row(const Params& P, int layer, int row, int lane) {
    const int hcol = lane * 4;
#pragma unroll
    for (int mx = 0; mx < 2; ++mx) {
        const uint2 uf = *(const uint2*)(P.r2 + ((size_t)(mx * 2 + 0) * MT + row) * 256 + hcol), ub = *(const uint2*)(P.r2 + ((size_t)(mx * 2 + 1) * MT + row) * 256 + hcol);
        float o[4];
        o[0] = __uint_as_float(uf.x << 16) + __uint_as_float(ub.x << 16); o[1] = __uint_as_float(uf.x & 0xffff0000u) + __uint_as_float(ub.x & 0xffff0000u);
        o[2] = __uint_as_float(uf.y << 16) + __uint_as_float(ub.y << 16); o[3] = __uint_as_float(uf.y & 0xffff0000u) + __uint_as_float(ub.y & 0xffff0000u);
        float ss = o[0] * o[0] + o[1] * o[1] + o[2] * o[2] + o[3] * o[3];
#pragma unroll
        for (int k = 8; k >= 1; k >>= 1) ss += __shfl_xor(ss, k);
        const float rstd = rsqrtf(ss * (1.f / 64.f) + EPS);
        const float* gain = (mx ? P.hgrn_norm : P.gdn_norm) + layer * 64 + (hcol & 63);
        const uint2 ug = *(const uint2*)(P.p + (size_t)row * INW + (mx ? P_HG : P_GZ) + hcol);
        float gt[4] = {__uint_as_float(ug.x << 16), __uint_as_float(ug.x & 0xffff0000u), __uint_as_float(ug.y << 16), __uint_as_float(ug.y & 0xffff0000u)};
        float r[4];
#pragma unroll
        for (int k = 0; k < 4; ++k) r[k] = o[k] * rstd * gain[k] * silu_f(gt[k]);
        uint2 ov; ov.x = cvt_pk_bf16(r[0], r[1]); ov.y = cvt_pk_bf16(r[2], r[3]);
        *(uint2*)(P.hm + (size_t)row * D + (mx ? 768 : 0) + hcol) = ov;
    }
}

#ifdef DBG_STOP
__device__ void dbg_dump(const Params& P, int k) {
    for (size_t i = (size_t)blockIdx.x * 256 + threadIdx.x; i < (size_t)ML * D; i += (size_t)gridDim.x * 256) {
        const int r = (int)(i >> 10), c = (int)(i & 1023);
        float v = 0.f;
        if (k == 1 || k == 5) v = bf2f(P.hm[(size_t)r * D + c]) + ((r < MC) ? bf2f(P.hm[(size_t)(ML + r) * D + c]) : 0.f);
        else if (k == 2 || k == 3) v = bf2f(P.p[(size_t)r * INW + c * 3]) + bf2f(P.p[(size_t)r * INW + c * 3 + 272]) + ((r < MC) ? bf2f(P.p[(size_t)(ML + r) * INW + c * 3]) : 0.f)
                                     + ((k == 3) ? bf2f(P.vt[(size_t)r * 2304 + c * 2]) : 0.f);
        else if (k == 4) v = (c >= 256 && c < 768) ? bf2f(P.hm[(size_t)r * D + c]) : bf2f(P.r2[((size_t)(c >> 8) * MT + r) * 256 + (c & 255)]) + bf2f(P.r2[((size_t)((c >> 8) + 1) * MT + r) * 256 + (c & 255)]);
        else if (k == 6) v = ((const float*)P.p)[(size_t)r * D + c];
        else if (k == 7) v = P.out[i] + bf2f(P.hm[(size_t)r * D + c]);
        else if (k == 8) v = bf2f(P.p[(size_t)r * FF + c * 2]) + bf2f(P.p[(size_t)r * FF + c + 1700]);
        else if (k == 9) v = bf2f(P.r2[(size_t)r * D + c]);
        else if (k == 0) v = (c < 864 ? P.mod[(size_t)(r % 18) * NMOD + (r / 18) * 6 % 5000 + c] : 0.f) + bf2f(P.w_inT[(size_t)(r % INP) * D + c]) + bf2f(P.w_upT[(size_t)(r % FF2) * D + c]) + bf2f(P.w_downT[(size_t)(r % D) * FF + c * 2]) + bf2f(P.w_outT[(size_t)(r % D) * D + c]);
        if (k != 7) P.out[i] = v; else P.out[i] = v;
    }
}
#define DBG_CHECK(k, l) if (DBG_STOP == (k) && (l) == DBG_LAYER) { dbg_dump(P, k); return; }
#else
#define DBG_CHECK(k, l)
#endif

__global__ void __launch_bounds__(256, 2) mega(Params P) {
    extern __shared__ __attribute__((aligned(16))) char lds[];
    __shared__ uint4 xb_words;
    __shared__ int s_item;
    cg::grid_group grid = cg::this_grid();
    const int tid = threadIdx.x, wid = tid >> 6, lane = tid & 63;
    if (tid == 0) xb_words = make_uint4(0u, 0u, 0u, 0u);
    __syncthreads();
    XcdBarrier xb = xcd_barrier_post(P.bar, (volatile LAS unsigned*)&xb_words);

    for (int it = blockIdx.x; it < 864 + ADA_ITEMS; it += gridDim.x) {
        if (it < ADA_ITEMS) ada_item(P, it, (float*)lds); else convert_item(P, 0, it - ADA_ITEMS, (float*)lds);
    }
    if (P.bar == nullptr) grid.sync();
    xcd_barrier(xb);
    DBG_CHECK(0, 0)
    resnorm_phase(P, 0, 0, MT);
    xcd_barrier(xb);
    DBG_CHECK(1, 0)

    for (int layer = 0; layer < 2; ++layer) {
        const bool with_ctx = layer == 0;
        const int Mrows = with_ctx ? MT : ML;
#ifndef NO_G1
        gemm_phase<EPI_P>(P.hm, D, MT, P.w_inT, D, INP / 128, P.p, INW, INW, lds);
#endif
        xcd_barrier(xb);
        DBG_CHECK(2, layer)
        { float cwr[24];
          const float* cwp = P.gdn_conv_w + (size_t)layer * 3 * 768 + (lane >> 5) * 256 + (lane & 31) * 8;
#pragma unroll
          for (int q = 0; q < 8; ++q) { cwr[q] = cwp[q]; cwr[8 + q] = cwp[768 + q]; cwr[16 + q] = cwp[1536 + q]; }
          for (int it = blockIdx.x; it < 4608; it += gridDim.x) { qkprep_rows(P, layer, it * 4 + wid, lane); gdnprep_row(P, layer, it * 4 + wid, lane, cwr); } }
        for (int it = blockIdx.x; it < VT_ITEMS; it += gridDim.x) vt_item(P, it, lds);
        xcd_barrier(xb);
        DBG_CHECK(3, layer)
        {
            const int n_scan = 128, n_attn_lat = 1024, n_attn_ctx = with_ctx ? 128 : 0;
            const int n_attn = n_scan + n_attn_lat + n_attn_ctx;
            const int n_conv = (layer == 0) ? (CONV_ITEMS - 864) + 864 : (CONV_ITEMS - 864);
            const int total = n_attn + n_conv;
            unsigned* ctr = P.ctr + layer * 64;
            for (;;) {
                __syncthreads();
                if (tid == 0) s_item = (int)atomicAdd(ctr, 1u);
                __syncthreads();
                const int it = s_item;
                if (it >= total) break;
                if (it >= n_attn) { const int cidx = it - n_attn;
                    if (layer == 0) { if (cidx < CONV_ITEMS - 864) convert_item(P, 0, 864 + cidx, (float*)lds); else convert_item(P, 1, cidx - (CONV_ITEMS - 864), (float*)lds); }
                    else convert_item(P, 1, 864 + cidx, (float*)lds);
                    continue; }
                if (it < 64) {
                    gdn_chunked(P, layer, it, lds);
                } else if (it < 128) {
                    hgrn_chunked(P, layer, it - 64, lds);
                }
#ifndef NO_ATTN
                else if (it < 128 + 1024) { const int a = it - 128; const int type = a >> 9, r = a & 511; attn_item(P, layer, type, r >> 6, (r >> 5) & 1, r & 31, false, lds); }
                else { const int a = it - 1152; const int type = a >> 6, r = a & 63; attn_item(P, layer, type, r >> 3, (r >> 2) & 1, r & 3, true, lds); }
#endif
            }
        }
        xcd_barrier(xb);
        DBG_CHECK(4, layer)
        for (int row = blockIdx.x * 4 + wid; row < Mrows; row += gridDim.x * 4) scanfin_row(P, layer, row, lane);
        xcd_barrier(xb);
        DBG_CHECK(5, layer)
#ifndef NO_G2
        gemm_phase<EPI_BF16>(P.hm, D, Mrows, P.w_outT, D, D / 128, (void*)P.p, D, D, lds);
#endif
        xcd_barrier(xb);
        DBG_CHECK(6, layer)
        resnorm_phase(P, layer, 1, Mrows);
        xcd_barrier(xb);
        DBG_CHECK(7, layer)
#ifndef NO_G3
        ffnup_phase(P, layer, with_ctx, lds);
#endif
        xcd_barrier(xb);
        DBG_CHECK(8, layer)
#ifndef NO_G4
        gemm_phase<EPI_BF16>(P.p, FF, Mrows, P.w_downT, FF, D / 128, (void*)P.r2, D, D, lds);
#endif
        xcd_barrier(xb);
        DBG_CHECK(9, layer)
        resnorm_phase(P, layer, 2, Mrows);
        if (layer == 0) {
            xcd_barrier(xb);
        }
    }
}

extern "C" void kernel_launch(void* const* d_in, const int* in_sizes, int n_in, void* d_out, int out_size, void* d_ws, size_t ws_size, hipStream_t stream) {
    Params P{};
    const float* const* in = (const float* const*)d_in;
    P.x = in[0]; P.c = in[1]; P.ctx = in[2]; P.c_ctx = in[3]; P.ada_w = in[4]; P.ada_b = in[5]; P.n_pre_mix = in[6]; P.n_post_mix = in[7]; P.n_pre_ffn = in[8]; P.n_post_ffn = in[9];
    P.w_in = in[10]; P.w_out = in[11]; P.gdn_conv_w = in[12]; P.gdn_a_log = in[13]; P.gdn_dt_bias = in[14]; P.gdn_norm = in[15]; P.attn_q_norm = in[16]; P.attn_k_norm = in[17];
    P.swa_sink = in[18]; P.hgrn_lb_raw = in[19]; P.hgrn_norm = in[20]; P.ffn_w_up = in[21]; P.ffn_conv_w = in[22]; P.ffn_conv_b = in[23]; P.ffn_w_down = in[24];
    P.out = (float*)d_out;
    char* ws = (char*)d_ws; size_t off = 0;
    auto take = [&](size_t bytes) { char* p = ws + off; off += (bytes + 255) & ~(size_t)255; return p; };
    const size_t ctl_bytes = 16384 + 1024 + (size_t)2 * 9 * NMOD * 4;
    P.bar = (unsigned*)take(16384); P.ctr = (unsigned*)take(1024); P.mod = (float*)take((size_t)2 * 9 * NMOD * 4);
    const size_t ctl_total = off;
    P.w_inT = (bf16_t*)take((size_t)INP * D * 2); P.w_outT = (bf16_t*)take((size_t)D * D * 2); P.w_upT = (bf16_t*)take((size_t)FF2 * D * 2); P.w_downT = (bf16_t*)take((size_t)D * FF * 2);
    P.xc = (float*)take((size_t)MC * D * 4);
    P.hm = (bf16_t*)take((size_t)MT * D * 2);
    P.p = (bf16_t*)take((size_t)MT * INW * 2);
    P.r2 = (bf16_t*)take((size_t)MT * D * 2);
    P.vt = (bf16_t*)take((size_t)2 * 8 * 2 * 64 * VT_LD * 2);
    P.adapart = (float*)P.r2;
    P.gqk = (bf16_t*)take((size_t)MT * 512 * 2);
    (void)ctl_bytes;
    if (off > ws_size) { fprintf(stderr, "workspace too small: need %zu have %zu\n", off, ws_size); return; }
    (void)hipMemsetAsync(ws, 0, ctl_total, stream);
    static int grid_blocks = 0;
    if (!grid_blocks) {
        if (hipFuncSetAttribute((const void*)mega, hipFuncAttributeMaxDynamicSharedMemorySize, LDS_BYTES) != hipSuccess) { fprintf(stderr, "hipFuncSetAttribute failed\n"); return; }
        int dev = 0, cus = 0, per_cu = 0;
        (void)hipGetDevice(&dev);
        (void)hipDeviceGetAttribute(&cus, hipDeviceAttributeMultiprocessorCount, dev);
        (void)hipOccupancyMaxActiveBlocksPerMultiprocessor(&per_cu, (const void*)mega, 256, LDS_BYTES);
        if (per_cu > 2) per_cu = 2;
        if (per_cu < 1) per_cu = 1;
        grid_blocks = cus * per_cu;
    }
    void* args[] = {&P};
    hipError_t e = hipLaunchCooperativeKernel((const void*)mega, dim3(grid_blocks), dim3(256), args, LDS_BYTES, stream);
    if (e != hipSuccess) fprintf(stderr, "cooperative launch failed: %s (grid %d)\n", hipGetErrorString(e), grid_blocks);
}
```

```cpp
#include <hip/hip_runtime.h>
#include <hip/hip_cooperative_groups.h>
#include <cstdio>
#include <cstdint>
namespace cg = cooperative_groups;

typedef unsigned short bf16_t;
typedef short bf16x8 __attribute__((ext_vector_type(8)));
typedef float f32x4 __attribute__((ext_vector_type(4)));
typedef unsigned u32x4 __attribute__((ext_vector_type(4)));
#define LAS __attribute__((address_space(3)))

constexpr int D = 1024, NB = 8, SEQ = 2048, CTX = 256;
constexpr int ML = NB * SEQ, MC = NB * CTX, MT = ML + MC;
constexpr int INW = 3344, INP = 3456, FF = 2816, FF2 = 5632;
constexpr int NMOD = 6 * D;
constexpr int P_GQ = 0, P_GK = 256, P_GV = 512, P_GZ = 768, P_AQ = 1024, P_AK = 1280, P_AV = 1408, P_WQ = 1536, P_WK = 1792, P_WV = 1920,
              P_HQ = 2048, P_HF = 2304, P_HI = 2816, P_HG = 3072, P_BETA = 3328, P_A = 3336;
constexpr float EPS = 1e-6f;
constexpr int LDS_BYTES = 65536;
constexpr int VT_LD = CTX + SEQ;

struct Params {
    const float *x, *c, *ctx, *c_ctx, *ada_w, *ada_b, *n_pre_mix, *n_post_mix, *n_pre_ffn, *n_post_ffn, *w_in, *w_out, *gdn_conv_w, *gdn_a_log,
        *gdn_dt_bias, *gdn_norm, *attn_q_norm, *attn_k_norm, *swa_sink, *hgrn_lb_raw, *hgrn_norm, *ffn_w_up, *ffn_conv_w, *ffn_conv_b, *ffn_w_down;
    float* out;
    unsigned* bar;
    unsigned* ctr;
    float* mod;
    float* adapart;
    bf16_t *w_inT, *w_outT, *w_upT, *w_downT;
    float* xc;
    bf16_t* hm;
    bf16_t* p;
    bf16_t* r2;
    bf16_t* vt;
    bf16_t* gqk;
};

__device__ __forceinline__ float bf2f(bf16_t v) { return __uint_as_float(((unsigned)v) << 16); }
typedef __bf16 bf16v2 __attribute__((ext_vector_type(2)));
typedef float f32v2 __attribute__((ext_vector_type(2)));
__device__ __forceinline__ unsigned cvt_pk_bf16(float lo, float hi) { const f32v2 v = {lo, hi}; return __builtin_bit_cast(unsigned, __builtin_convertvector(v, bf16v2)); }
__device__ __forceinline__ bf16_t f2bf(float f) { return (bf16_t)(cvt_pk_bf16(f, 0.f) & 0xffffu); }
__device__ __forceinline__ float silu_f(float x) { return x * __builtin_amdgcn_rcpf(1.f + __expf(-x)); }
__device__ __forceinline__ float sigmoid_f(float x) { return __builtin_amdgcn_rcpf(1.f + __expf(-x)); }
__device__ __forceinline__ float wave_sum(float v) {
#pragma unroll
    for (int o = 32; o >= 1; o >>= 1) v += __shfl_xor(v, o);
    return v;
}
template <int CTRL> __device__ __forceinline__ float dpp_f(float x) {
    return __int_as_float(__builtin_amdgcn_update_dpp(0, __float_as_int(x), CTRL, 0xF, 0xF, true));
}
__device__ __forceinline__ float red8(float x) {
    x += dpp_f<0xB1>(x); x += dpp_f<0x4E>(x); x += dpp_f<0x141>(x); return x;
}
__device__ __forceinline__ void unpack8(u32x4 v, float* o) {
    o[0] = __uint_as_float(v[0] << 16); o[1] = __uint_as_float(v[0] & 0xffff0000u);
    o[2] = __uint_as_float(v[1] << 16); o[3] = __uint_as_float(v[1] & 0xffff0000u);
    o[4] = __uint_as_float(v[2] << 16); o[5] = __uint_as_float(v[2] & 0xffff0000u);
    o[6] = __uint_as_float(v[3] << 16); o[7] = __uint_as_float(v[3] & 0xffff0000u);
}

__device__ __forceinline__ int opaque_tid() { int t = threadIdx.x; asm volatile("" : "+v"(t)); return t; }
#define XB_TMO      128
#define XB_XCNT(j)  (256  + 64 * (j))
#define XB_XSUB(j)  (1280 + 64 * (j))
#define XB_XGEN(j)  (2304 + 64 * (j))
#define XB_TOP      3328
#define XB_TOPGEN   3392
#define XCD_BAR_WORDS 3456
#define XB_SPIN_CAP (1u << 22)
__device__ __forceinline__ unsigned xb_ld(unsigned* p)              { return __hip_atomic_load(p, __ATOMIC_RELAXED, __HIP_MEMORY_SCOPE_AGENT); }
__device__ __forceinline__ unsigned xb_add(unsigned* p, unsigned v) { return __hip_atomic_fetch_add(p, v, __ATOMIC_RELAXED, __HIP_MEMORY_SCOPE_AGENT); }
__device__ __forceinline__ unsigned xb_xcc_id() { return (unsigned)__builtin_amdgcn_s_getreg((3 << 11) | 20) & 0xFu; }
#define XB_SPIN(cond, bar) do { unsigned _sp = 0; while (cond) { __builtin_amdgcn_s_sleep(1); \
    if ((++_sp & 255u) == 0u) { if (xb_ld(&(bar)[XB_TMO])) break; if (_sp > XB_SPIN_CAP) { atomicAdd(&(bar)[XB_TMO], 1u); break; } } } } while (0)
struct XcdBarrier { unsigned* bar; unsigned x; volatile LAS unsigned* st; };
__device__ __forceinline__ XcdBarrier xcd_barrier_post(unsigned* bar, volatile LAS unsigned* st) {
    XcdBarrier b; b.bar = bar; b.x = xb_xcc_id(); b.st = st;
    if (threadIdx.x == 0) (void)xb_add(&bar[XB_XCNT(b.x)], 1u);
    return b;
}
__device__ __forceinline__ void xcd_barrier_complete(unsigned* bar, unsigned x, unsigned& nloc, unsigned& nx) {
    const unsigned G = gridDim.x * gridDim.y * gridDim.z;
    unsigned sum, cnt, mine, sp = 0u;
    for (;;) {
        sum = 0u; cnt = 0u; mine = 0u;
#pragma unroll
        for (unsigned j = 0; j < 16; ++j) { const unsigned c = xb_ld(&bar[XB_XCNT(j)]); sum += c; cnt += (c > 0u) ? 1u : 0u; mine = (j == x) ? c : mine; }
        if (sum == G) break;
        __builtin_amdgcn_s_sleep(1);
        if ((++sp & 255u) == 0u) { if (xb_ld(&bar[XB_TMO])) break; if (sp > XB_SPIN_CAP) { atomicAdd(&bar[XB_TMO], 1u); break; } }
    }
    nloc = mine > 0u ? mine : 1u; nx = cnt > 0u ? cnt : 1u;
}
__device__ __forceinline__ void xcd_barrier(const XcdBarrier& b) {
    asm volatile("s_waitcnt vmcnt(0)" ::: "memory");
    __syncthreads();
    if (threadIdx.x == 0) {
        unsigned* bar = b.bar;
        __builtin_amdgcn_s_waitcnt(0);
        unsigned nloc = b.st[0], nx = b.st[1];
        if (nloc == 0u) { xcd_barrier_complete(bar, b.x, nloc, nx); b.st[0] = nloc; b.st[1] = nx; }
        const unsigned old = xb_add(&bar[XB_XSUB(b.x)], 1u);
        const unsigned gen = old / nloc;
        if (old + 1u == (gen + 1u) * nloc) {
            __builtin_amdgcn_fence(__ATOMIC_RELEASE, "agent");
            asm volatile("s_waitcnt vmcnt(0)" ::: "memory");
            const unsigned og = xb_add(&bar[XB_TOP], 1u);
            const unsigned tg = og / nx;
            if (og + 1u == (tg + 1u) * nx) xb_add(&bar[XB_TOPGEN], 1u);
            else XB_SPIN(xb_ld(&bar[XB_TOPGEN]) == tg, bar);
            __builtin_amdgcn_fence(__ATOMIC_ACQUIRE, "agent");
            xb_add(&bar[XB_XGEN(b.x)], 1u);
            asm volatile("s_waitcnt vmcnt(0)" ::: "memory");
        } else {
            XB_SPIN(xb_ld(&bar[XB_XGEN(b.x)]) == gen, bar);
            __builtin_amdgcn_fence(__ATOMIC_ACQUIRE, "agent");
            asm volatile("s_waitcnt vmcnt(0)" ::: "memory");
        }
    }
    __syncthreads();
}

__device__ __forceinline__ void convert_tile(const float* __restrict__ W, int K, int N, bf16_t* __restrict__ Wt, int n0, int k0, int mode, float* tile) {
    const int tid = opaque_tid(), i = tid & 63, j = tid >> 6;
    const int n = n0 + i; int src = n;
    if (mode == 1) src = (n < 1024) ? n : (n < 3328 ? n + 16 : (n < 3344 ? 1024 + (n - 3328) : -1));
    else if (mode == 2) { const int blk = n >> 7, r = n & 127; src = (r < 64) ? blk * 64 + r : FF + blk * 64 + (r - 64); }
#pragma unroll 4
    for (int kk = 0; kk < 16; ++kk) { const int k = kk * 4 + j; const float v = (src >= 0) ? W[(size_t)(k0 + k) * N + src] : 0.f; tile[k * 65 + i] = v; }
    __syncthreads();
    const int nn = tid >> 2, ks = (tid & 3) * 16;
    unsigned w[8];
#pragma unroll
    for (int q = 0; q < 8; ++q) w[q] = cvt_pk_bf16(tile[(ks + 2 * q) * 65 + nn], tile[(ks + 2 * q + 1) * 65 + nn]);
    uint4* dst = (uint4*)(Wt + (size_t)(n0 + nn) * K + k0 + ks);
    dst[0] = make_uint4(w[0], w[1], w[2], w[3]); dst[1] = make_uint4(w[4], w[5], w[6], w[7]);
    __syncthreads();
}
constexpr int CONV_ITEMS = 864 + 256 + 1408 + 704;
__device__ void convert_item(const Params& P, int layer, int it, float* tile) {
    if (it < 864) { const int nt = it >> 4, kt = it & 15; convert_tile(P.w_in + (size_t)layer * D * INW, D, INW, P.w_inT, nt * 64, kt * 64, 1, tile); return; }
    it -= 864;
    if (it < 256) { const int nt = it >> 4, kt = it & 15; convert_tile(P.w_out + (size_t)layer * D * D, D, D, P.w_outT, nt * 64, kt * 64, 0, tile); return; }
    it -= 256;
    if (it < 1408) { const int nt = it >> 4, kt = it & 15; convert_tile(P.ffn_w_up + (size_t)layer * D * FF2, D, FF2, P.w_upT, nt * 64, kt * 64, 2, tile); return; }
    it -= 1408;
    { const int nt = it / 44, kt = it % 44; convert_tile(P.ffn_w_down + (size_t)layer * FF * D, FF, D, P.w_downT, nt * 64, kt * 64, 0, tile); }
}
constexpr int ADA_ITEMS = 2 * 24 * 16;
__device__ void ada_item(const Params& P, int item, float* lds) {
    const int tid = opaque_tid();
    const int kc = item & 15, cc = (item >> 4) % 24, layer = item / (16 * 24);
    for (int i = tid; i < 9 * 64; i += 256) { const int r = i >> 6, k = i & 63; const float v = (r < 8) ? P.c[r * D + kc * 64 + k] : P.c_ctx[kc * 64 + k]; lds[i] = silu_f(v); }
    __syncthreads();
    const int col = cc * 256 + tid;
    float acc[9];
#pragma unroll
    for (int r = 0; r < 9; ++r) acc[r] = 0.f;
    const float* w = P.ada_w + (size_t)layer * D * NMOD + (size_t)(kc * 64) * NMOD + col;
#pragma unroll 8
    for (int k = 0; k < 64; ++k) { const float wv = w[(size_t)k * NMOD];
#pragma unroll
        for (int r = 0; r < 9; ++r) acc[r] += lds[r * 64 + k] * wv; }
    float* part = P.adapart + (size_t)item * 9 * 256;
#pragma unroll
    for (int r = 0; r < 9; ++r) __hip_atomic_store(part + r * 256 + tid, acc[r], __ATOMIC_RELAXED, __HIP_MEMORY_SCOPE_AGENT);
    __threadfence();
    __syncthreads();
    unsigned* flag = (unsigned*)(lds + 600);
    if (tid == 0) { const unsigned old = __hip_atomic_fetch_add(P.ctr + 128 + layer * 24 + cc, 1u, __ATOMIC_ACQ_REL, __HIP_MEMORY_SCOPE_AGENT); *flag = old; }
    __syncthreads();
    const bool last = (*flag == 15u);
    if (last) {
        __threadfence();
        const float bb = P.ada_b[layer * NMOD + col];
#pragma unroll
        for (int r = 0; r < 9; ++r) { float sum = bb;
            for (int k2 = 0; k2 < 16; ++k2) sum += __hip_atomic_load(P.adapart + (size_t)((layer * 24 + cc) * 16 + k2) * 9 * 256 + r * 256 + tid, __ATOMIC_RELAXED, __HIP_MEMORY_SCOPE_AGENT);
            P.mod[(size_t)(layer * 9 + r) * NMOD + col] = sum; }
    }
    __syncthreads();
}

struct RowP { const float* xin; float* xout; const void* branch; const float *gate, *gpost, *gnext, *shift, *scale; bf16_t* hout; };
template <int BR>
__device__ __forceinline__ void rn_load(const RowP& r, f32x4 (&x)[4], f32x4 (&br)[4], int lane) {
#pragma unroll
    for (int g = 0; g < 4; ++g) x[g] = __builtin_nontemporal_load((const f32x4*)(r.xin + g * 256 + lane * 4));
    if (BR != 0) {
#pragma unroll
        for (int g = 0; g < 4; ++g) {
            if (BR == 1) br[g] = __builtin_nontemporal_load((const f32x4*)((const float*)r.branch + g * 256 + lane * 4));
            else { const uint2 u = *(const uint2*)((const bf16_t*)r.branch + g * 256 + lane * 4);
                   br[g] = (f32x4){__uint_as_float(u.x << 16), __uint_as_float(u.x & 0xffff0000u), __uint_as_float(u.y << 16), __uint_as_float(u.y & 0xffff0000u)}; }
        }
    }
}
template <int BR>
__device__ __forceinline__ void rn_compute(const RowP& r, f32x4 (&x)[4], f32x4 (&br)[4], int lane) {
    f32x4 gt[4], gp[4], gn[4], sh[4], sc[4];
    if (BR != 0) {
#pragma unroll
        for (int g = 0; g < 4; ++g) { gt[g] = *(const f32x4*)(r.gate + g * 256 + lane * 4); gp[g] = *(const f32x4*)(r.gpost + g * 256 + lane * 4); }
    }
    if (r.hout) {
#pragma unroll
        for (int g = 0; g < 4; ++g) { gn[g] = *(const f32x4*)(r.gnext + g * 256 + lane * 4); sh[g] = *(const f32x4*)(r.shift + g * 256 + lane * 4); sc[g] = *(const f32x4*)(r.scale + g * 256 + lane * 4); }
    }
    if (BR != 0) {
        float ss = 0.f;
#pragma unroll
        for (int g = 0; g < 4; ++g) ss += br[g][0] * br[g][0] + br[g][1] * br[g][1] + br[g][2] * br[g][2] + br[g][3] * br[g][3];
        ss = wave_sum(ss);
        const float rstd = rsqrtf(ss * (1.f / D) + EPS);
#pragma unroll
        for (int g = 0; g < 4; ++g) x[g] += gt[g] * (br[g] * rstd * gp[g]);
#pragma unroll
        for (int g = 0; g < 4; ++g) __builtin_nontemporal_store(x[g], (f32x4*)(r.xout + g * 256 + lane * 4));
    }
    if (r.hout) {
        float ss = 0.f;
#pragma unroll
        for (int g = 0; g < 4; ++g) ss += x[g][0] * x[g][0] + x[g][1] * x[g][1] + x[g][2] * x[g][2] + x[g][3] * x[g][3];
        ss = wave_sum(ss);
        const float rstd = rsqrtf(ss * (1.f / D) + EPS);
#pragma unroll
        for (int g = 0; g < 4; ++g) { const f32x4 h = (x[g] * rstd * gn[g]) * (1.f + sc[g]) + sh[g];
            uint2 o; o.x = cvt_pk_bf16(h[0], h[1]); o.y = cvt_pk_bf16(h[2], h[3]);
            *(uint2*)(r.hout + g * 256 + lane * 4) = o; }
    }
}
template <int KIND>
__device__ __forceinline__ RowP rn_setup(const Params& P, int layer, int row) {
    const bool lat = row < ML;
    const int cond = lat ? (row >> 11) : 8;
    const float* modl = P.mod + (size_t)(layer * 9 + cond) * NMOD;
    bf16_t* h = P.hm + (size_t)row * D;
    RowP r{};
    if (KIND == 0) {
        r.xin = lat ? P.x + (size_t)row * D : P.ctx + (size_t)(row - ML) * D;
        r.gnext = P.n_pre_mix + layer * D; r.shift = modl; r.scale = modl + D; r.hout = h;
    } else if (KIND == 1) {
        r.xin = (layer == 0) ? (lat ? P.x + (size_t)row * D : P.ctx + (size_t)(row - ML) * D) : (lat ? P.out + (size_t)row * D : P.xc + (size_t)(row - ML) * D);
        r.xout = lat ? P.out + (size_t)row * D : P.xc + (size_t)(row - ML) * D;
        r.branch = P.p + (size_t)row * D; r.gate = modl + 2 * D; r.gpost = P.n_post_mix + layer * D;
        r.gnext = P.n_pre_ffn + layer * D; r.shift = modl + 3 * D; r.scale = modl + 4 * D; r.hout = h;
    } else {
        float* xo = lat ? P.out + (size_t)row * D : P.xc + (size_t)(row - ML) * D;
        const bool nxt = layer == 0;
        const float* modn = P.mod + (size_t)((layer + 1) * 9 + cond) * NMOD;
        r.xin = xo; r.xout = xo; r.branch = P.r2 + (size_t)row * D; r.gate = modl + 5 * D; r.gpost = P.n_post_ffn + layer * D;
        if (nxt) { r.gnext = P.n_pre_mix + (layer + 1) * D; r.shift = modn; r.scale = modn + D; r.hout = h; }
    }
    return r;
}
template <int KIND>
__device__ __forceinline__ void resnorm_loop(const Params& P, int layer, int nrows) {
    constexpr int BR = (KIND == 0) ? 0 : 2;
    const int tid_ = opaque_tid(); const int wid = tid_ >> 6, lane = tid_ & 63;
    const int stride = gridDim.x * 4;
    int row = blockIdx.x * 4 + wid;
    if (row >= nrows) return;
    f32x4 x[4], br[4];
    RowP cur = rn_setup<KIND>(P, layer, row);
    rn_load<BR>(cur, x, br, lane);
    for (;;) {
        const int nrow = row + stride;
        f32x4 xn[4], bn[4]; RowP nxt{};
        const bool more = nrow < nrows;
        if (more) { nxt = rn_setup<KIND>(P, layer, nrow); rn_load<BR>(nxt, xn, bn, lane); }
        rn_compute<BR>(cur, x, br, lane);
        if (!more) break;
#pragma unroll
        for (int g = 0; g < 4; ++g) { x[g] = xn[g]; br[g] = bn[g]; }
        cur = nxt; row = nrow;
    }
}
__device__ void resnorm_phase(const Params& P, int layer, int kind, int nrows) {
    if (kind == 0) resnorm_loop<0>(P, layer, nrows); else if (kind == 1) resnorm_loop<1>(P, layer, nrows); else resnorm_loop<2>(P, layer, nrows);
}

enum { EPI_P = 0, EPI_F32 = 1, EPI_BF16 = 2, EPI_FFNUP = 3 };
struct EpiArgs { void* out; int ldc; int ncols; const float* cw; const float* cb; int seq_lo, seq_hi, out_lo, out_hi, nblk; };
template <int EPI>
__device__ __forceinline__ void gemm_tile(const bf16_t* __restrict__ A, int lda, int arow_base, int arow_lo, int arow_hi, const bf16_t* __restrict__ Bt, int K, int n0,
                                          const EpiArgs& E, char* lds) {
    const int tid = opaque_tid(), wid = __builtin_amdgcn_readfirstlane(tid >> 6), lane = tid & 63, wm = wid >> 1, wn = wid & 1, lr = lane & 15, quad = lane >> 4;
    const int sr = tid >> 3, sc = (tid & 7) ^ (sr & 7);
    const bf16_t* ap[4]; const bf16_t* bp[4];
#pragma unroll
    for (int i = 0; i < 4; ++i) { int r = arow_base + sr + 32 * i; r = r < arow_lo ? arow_lo : (r >= arow_hi ? arow_hi - 1 : r);
        ap[i] = A + (size_t)r * lda + sc * 8; bp[i] = Bt + (size_t)(n0 + sr + 32 * i) * K + sc * 8; }
    LAS char* l3 = (LAS char*)lds;
    auto stage = [&](int kt, int buf) {
#pragma unroll
        for (int i = 0; i < 4; ++i) {
            __builtin_amdgcn_global_load_lds((const unsigned*)(ap[i] + kt * 64), (LAS unsigned*)(l3 + buf * 32768 + i * 4096 + wid * 1024), 16, 0, 0);
            __builtin_amdgcn_global_load_lds((const unsigned*)(bp[i] + kt * 64), (LAS unsigned*)(l3 + buf * 32768 + 16384 + i * 4096 + wid * 1024), 16, 0, 0);
        }
    };
    f32x4 acc[4][4];
#pragma unroll
    for (int mi = 0; mi < 4; ++mi)
#pragma unroll
        for (int ni = 0; ni < 4; ++ni) acc[mi][ni] = (f32x4){0.f, 0.f, 0.f, 0.f};
    const int nk = K >> 6;
    __syncthreads();
    stage(0, 0);
    for (int kt = 0; kt < nk; ++kt) {
        asm volatile("s_waitcnt vmcnt(0)" ::: "memory");
        __syncthreads();
        if (kt + 1 < nk) stage(kt + 1, (kt + 1) & 1);
        const char* As = lds + (kt & 1) * 32768; const char* Bs = As + 16384;
#pragma unroll
        for (int ks = 0; ks < 2; ++ks) {
            bf16x8 af[4], bfr[4];
            const int ch = ks * 4 + quad;
#pragma unroll
            for (int mi = 0; mi < 4; ++mi) { const int r = wm * 64 + mi * 16 + lr; af[mi] = *(const bf16x8*)(As + r * 128 + ((ch ^ (r & 7)) * 16)); }
#pragma unroll
            for (int ni = 0; ni < 4; ++ni) { const int r = wn * 64 + ni * 16 + lr; bfr[ni] = *(const bf16x8*)(Bs + r * 128 + ((ch ^ (r & 7)) * 16)); }
            __builtin_amdgcn_s_setprio(1);
#pragma unroll
            for (int mi = 0; mi < 4; ++mi)
#pragma unroll
                for (int ni = 0; ni < 4; ++ni) acc[mi][ni] = __builtin_amdgcn_mfma_f32_16x16x32_bf16(bfr[ni], af[mi], acc[mi][ni], 0, 0, 0);
            __builtin_amdgcn_s_setprio(0);
        }
    }
#ifdef EXP_A
    if (EPI == EPI_FFNUP) {
#pragma unroll
        for (int mi = 0; mi < 4; ++mi) { const int i = wm * 64 + mi * 16 + lr; const int grow = arow_base + i;
#pragma unroll
            for (int ni = 0; ni < 4; ++ni) if (wn == 0 && i >= 1 && i <= 126 && grow < E.out_hi) { uint2 o; o.x = cvt_pk_bf16(acc[mi][ni][0], acc[mi][ni][1]); o.y = cvt_pk_bf16(acc[mi][ni][2], acc[mi][ni][3]);
                *(uint2*)((bf16_t*)E.out + (size_t)grow * FF + E.nblk * 64 + ni * 16 + quad * 4) = o; } }
    } else
#endif
    if (EPI == EPI_FFNUP) {
        __syncthreads();
        bf16_t* U = (bf16_t*)lds;
#pragma unroll
        for (int mi = 0; mi < 4; ++mi)
#pragma unroll
            for (int ni = 0; ni < 4; ++ni) { uint2 o; o.x = cvt_pk_bf16(acc[mi][ni][0], acc[mi][ni][1]); o.y = cvt_pk_bf16(acc[mi][ni][2], acc[mi][ni][3]);
                *(uint2*)(U + (wm * 64 + mi * 16 + lr) * 136 + wn * 64 + ni * 16 + quad * 4) = o; }
        __syncthreads();
        auto ld4 = [&](int r, int c) { const uint2 u = *(const uint2*)(U + r * 136 + c);
            return (f32x4){__uint_as_float(u.x << 16), __uint_as_float(u.x & 0xffff0000u), __uint_as_float(u.y << 16), __uint_as_float(u.y & 0xffff0000u)}; };
        const int j4 = (tid & 15) * 4; const int f0 = E.nblk * 64 + j4;
        f32x4 wg[3], wv[3];
#pragma unroll
        for (int kk = 0; kk < 3; ++kk) { wg[kk] = *(const f32x4*)(E.cw + kk * FF2 + f0); wv[kk] = *(const f32x4*)(E.cw + kk * FF2 + FF + f0); }
        const f32x4 bg = *(const f32x4*)(E.cb + f0), bv = *(const f32x4*)(E.cb + FF + f0);
#pragma unroll
        for (int rr = 0; rr < 8; ++rr) {
            const int i = (tid >> 4) + 16 * rr; const int grow = arow_base + i;
            if (i >= 1 && i <= 126 && grow >= E.out_lo && grow < E.out_hi) {
                const float mp = (grow - 1 >= E.seq_lo) ? 1.f : 0.f, mn = (grow + 1 < E.seq_hi) ? 1.f : 0.f;
                const f32x4 gp = ld4(i - 1, j4), gc = ld4(i, j4), gn = ld4(i + 1, j4);
                const f32x4 vp = ld4(i - 1, 64 + j4), vc = ld4(i, 64 + j4), vn = ld4(i + 1, 64 + j4);
                const f32x4 cg_ = wg[0] * gp * mp + wg[1] * gc + wg[2] * gn * mn + bg;
                const f32x4 cv_ = wv[0] * vp * mp + wv[1] * vc + wv[2] * vn * mn + bv;
                uint2 o; o.x = cvt_pk_bf16(silu_f(cg_[0]) * cv_[0], silu_f(cg_[1]) * cv_[1]); o.y = cvt_pk_bf16(silu_f(cg_[2]) * cv_[2], silu_f(cg_[3]) * cv_[3]);
                *(uint2*)((bf16_t*)E.out + (size_t)grow * FF + f0) = o;
            }
        }
    } else {
#pragma unroll
        for (int mi = 0; mi < 4; ++mi) {
            const int row = arow_base + wm * 64 + mi * 16 + lr;
#pragma unroll
            for (int ni = 0; ni < 4; ++ni) {
                const int col = n0 + wn * 64 + ni * 16 + quad * 4;
                if (EPI == EPI_F32) *(f32x4*)((float*)E.out + (size_t)row * E.ldc + col) = acc[mi][ni];
                else if (col < E.ncols) { uint2 o; o.x = cvt_pk_bf16(acc[mi][ni][0], acc[mi][ni][1]); o.y = cvt_pk_bf16(acc[mi][ni][2], acc[mi][ni][3]);
                    *(uint2*)((bf16_t*)E.out + (size_t)row * E.ldc + col) = o; }
            }
        }
    }
}
template <int EPI>
__device__ void gemm_phase(const bf16_t* A, int lda, int M, const bf16_t* Bt, int K, int ntn, void* out, int ldc, int ncols, char* lds) {
    const int ntm = M / 128, nt = ntm * ntn;
    EpiArgs E{}; E.out = out; E.ldc = ldc; E.ncols = ncols;
    if ((ntm & 7) == 0 && (gridDim.x & 7) == 0) {
        const int xcd = blockIdx.x & 7, lb = blockIdx.x >> 3, nlb = gridDim.x >> 3, per = (ntm >> 3) * ntn;
        const int mloc = ntm >> 3, nig = 8 * ntn;
        for (int q = lb; q < per; q += nlb) { const int gid = q / nig, fm = gid * 8, gsz = min(mloc - fm, 8), rr = q % nig; const int tm = (fm + rr % gsz) * 8 + xcd, tn = rr / gsz;
            gemm_tile<EPI>(A, lda, tm * 128, 0, M, Bt, K, tn * 128, E, lds); }
        return;
    }
    for (int t = blockIdx.x; t < nt; t += gridDim.x) {
        const int tm = t / ntn, tn = t % ntn;
        gemm_tile<EPI>(A, lda, tm * 128, 0, M, Bt, K, tn * 128, E, lds);
    }
}

__device__ __forceinline__ int swz4(int r) { return (0x78 >> (((r >> 2) & 3) * 2)) & 3; }
__device__ __forceinline__ void ffnup_tile256(const bf16_t* __restrict__ A, int arow_base, int arow_lo, int arow_hi, const bf16_t* __restrict__ Bt, int n0, const EpiArgs& E, int tn, char* lds) {
    const int tid = opaque_tid(), wid = __builtin_amdgcn_readfirstlane(tid >> 6), lane = tid & 63, wm = wid >> 1, wn = wid & 1, lr = lane & 15, quad = lane >> 4;
    constexpr int K = D, STG = 24576;
    unsigned aofs[2], bofs[4];
#pragma unroll
    for (int i = 0; i < 2; ++i) { const int rl = (i * 4 + wid) * 16 + (lane >> 2); const int c = (lane & 3) ^ swz4(rl);
        int r = arow_base + rl; r = r < arow_lo ? arow_lo : (r >= arow_hi ? arow_hi - 1 : r);
        aofs[i] = (unsigned)r * K + c * 8; }
#pragma unroll
    for (int i = 0; i < 4; ++i) { const int rl = (i * 4 + wid) * 16 + (lane >> 2); const int c = (lane & 3) ^ swz4(rl);
        bofs[i] = (unsigned)(n0 + rl) * K + c * 8; }
    LAS char* l3 = (LAS char*)lds;
    auto stage = [&](int kt, int buf) {
#pragma unroll
        for (int i = 0; i < 2; ++i) __builtin_amdgcn_global_load_lds((const unsigned*)(A + aofs[i] + kt * 32), (LAS unsigned*)(l3 + buf * STG + (i * 4 + wid) * 1024), 16, 0, 0);
#pragma unroll
        for (int i = 0; i < 4; ++i) __builtin_amdgcn_global_load_lds((const unsigned*)(Bt + bofs[i] + kt * 32), (LAS unsigned*)(l3 + buf * STG + 8192 + (i * 4 + wid) * 1024), 16, 0, 0);
    };
    f32x4 acc[4][8];
#pragma unroll
    for (int mi = 0; mi < 4; ++mi)
#pragma unroll
        for (int ni = 0; ni < 8; ++ni) acc[mi][ni] = (f32x4){0.f, 0.f, 0.f, 0.f};
    const int ra = wm * 64 + lr, rb = wn * 128 + lr;
    const int aoff0 = ra * 64 + ((quad ^ swz4(ra)) * 16), boff0 = 8192 + rb * 64 + ((quad ^ swz4(rb)) * 16);
    constexpr int nk = K >> 5;
    __syncthreads();
    stage(0, 0);
    for (int kt = 0; kt < nk; ++kt) {
        asm volatile("s_waitcnt vmcnt(0)" ::: "memory");
        __syncthreads();
        if (kt + 1 < nk) stage(kt + 1, (kt + 1) & 1);
        const char* Sb = lds + (kt & 1) * STG;
        bf16x8 af[4];
#pragma unroll
        for (int mi = 0; mi < 4; ++mi) af[mi] = *(const bf16x8*)(Sb + aoff0 + mi * 1024);
        __builtin_amdgcn_s_setprio(1);
#pragma unroll
        for (int nh = 0; nh < 4; ++nh) {
            bf16x8 bfr[2];
#pragma unroll
            for (int q = 0; q < 2; ++q) bfr[q] = *(const bf16x8*)(Sb + boff0 + (nh * 2 + q) * 1024);
#pragma unroll
            for (int mi = 0; mi < 4; ++mi)
#pragma unroll
                for (int q = 0; q < 2; ++q) acc[mi][nh * 2 + q] = __builtin_amdgcn_mfma_f32_16x16x32_bf16(bfr[q], af[mi], acc[mi][nh * 2 + q], 0, 0, 0);
        }
        __builtin_amdgcn_s_setprio(0);
    }
    bf16_t* U = (bf16_t*)lds;
    auto ld4 = [&](int r, int c) { const uint2 u = *(const uint2*)(U + r * 136 + c);
        return (f32x4){__uint_as_float(u.x << 16), __uint_as_float(u.x & 0xffff0000u), __uint_as_float(u.y << 16), __uint_as_float(u.y & 0xffff0000u)}; };
#pragma unroll
    for (int h = 0; h < 2; ++h) {
        const int j4 = (tid & 15) * 4; const int f0 = (2 * tn + h) * 64 + j4;
        f32x4 wg[3], wv[3];
#pragma unroll
        for (int kk = 0; kk < 3; ++kk) { wg[kk] = *(const f32x4*)(E.cw + kk * FF2 + f0); wv[kk] = *(const f32x4*)(E.cw + kk * FF2 + FF + f0); }
        const f32x4 bg = *(const f32x4*)(E.cb + f0), bv = *(const f32x4*)(E.cb + FF + f0);
        __syncthreads();
        if (wn == h) {
#pragma unroll
            for (int mi = 0; mi < 4; ++mi)
#pragma unroll
                for (int ni = 0; ni < 8; ++ni) { uint2 o; o.x = cvt_pk_bf16(acc[mi][ni][0], acc[mi][ni][1]); o.y = cvt_pk_bf16(acc[mi][ni][2], acc[mi][ni][3]);
                    *(uint2*)(U + (wm * 64 + mi * 16 + lr) * 136 + ni * 16 + quad * 4) = o; }
        }
        __syncthreads();
#pragma unroll
        for (int rr = 0; rr < 8; ++rr) {
            const int i = (tid >> 4) + 16 * rr; const int grow = arow_base + i;
            if (i >= 1 && i <= 126 && grow >= E.out_lo && grow < E.out_hi) {
                const float mp = (grow - 1 >= E.seq_lo) ? 1.f : 0.f, mn = (grow + 1 < E.seq_hi) ? 1.f : 0.f;
                const f32x4 gp = ld4(i - 1, j4), gc = ld4(i, j4), gn = ld4(i + 1, j4);
                const f32x4 vp = ld4(i - 1, 64 + j4), vc = ld4(i, 64 + j4), vn = ld4(i + 1, 64 + j4);
                const f32x4 cg_ = wg[0] * gp * mp + wg[1] * gc + wg[2] * gn * mn + bg;
                const f32x4 cv_ = wv[0] * vp * mp + wv[1] * vc + wv[2] * vn * mn + bv;
                uint2 o; o.x = cvt_pk_bf16(silu_f(cg_[0]) * cv_[0], silu_f(cg_[1]) * cv_[1]); o.y = cvt_pk_bf16(silu_f(cg_[2]) * cv_[2], silu_f(cg_[3]) * cv_[3]);
                *(uint2*)((bf16_t*)E.out + (size_t)grow * FF + f0) = o;
            }
        }
    }
}

__device__ void ffnup_phase(const Params& P, int layer, bool with_ctx, char* lds) {
    const int ntn = FF2 / 256;
    const int ntm = 8 * 17 + (with_ctx ? 8 * 3 : 0);
    const int nt = ntm * ntn;
    EpiArgs E{}; E.out = P.p; E.cw = P.ffn_conv_w + (size_t)layer * 3 * FF2; E.cb = P.ffn_conv_b + (size_t)layer * FF2;
    const bool xcdord = ((ntm & 7) == 0) && ((gridDim.x & 7) == 0);
    const int xcd = blockIdx.x & 7, lb = blockIdx.x >> 3, nlb = gridDim.x >> 3, per = (ntm >> 3) * ntn;
    for (int t = xcdord ? lb : blockIdx.x; t < (xcdord ? per : nt); t += (xcdord ? nlb : gridDim.x)) {
        int tm, tn;
        if (xcdord) { const int mloc = ntm >> 3, nig = 8 * ntn, gid = t / nig, fm = gid * 8, gsz = min(mloc - fm, 8), rr = t % nig; tm = (fm + rr % gsz) * 8 + xcd; tn = rr / gsz; }
        else { tm = t / ntn; tn = t % ntn; }
        int s0, L, j;
        if (tm < 136) { s0 = (tm / 17) * SEQ; L = SEQ; j = tm % 17; } else { const int q = tm - 136; s0 = ML + (q / 3) * CTX; L = CTX; j = q % 3; }
        E.seq_lo = s0; E.seq_hi = s0 + L; E.out_lo = s0 + 126 * j; E.out_hi = min(s0 + 126 * j + 126, s0 + L); E.nblk = tn;
        ffnup_tile256(P.hm, s0 + 126 * j - 1, s0, s0 + L, P.w_upT, tn * 256, E, tn, lds);
    }
}

constexpr int VT_ITEMS = 2 * 8 * 2 * 36;
__device__ void vt_item(const Params& P, int it, char* lds) {
    const int tid = opaque_tid();
    const int pt = it % 36, kvh = (it / 36) & 1, b = (it / 72) & 7, type = it / 576;
    const int row0 = (pt < 4) ? (ML + b * CTX + pt * 64) : (b * SEQ + (pt - 4) * 64);
    const int vcol = (type ? P_WV : P_AV) + kvh * 64;
    bf16_t* T = (bf16_t*)lds;
    { const int pos = tid >> 2, seg = (tid & 3) * 16;
      const uint4* src = (const uint4*)(P.p + (size_t)(row0 + pos) * INW + vcol + seg);
      const uint4 a = src[0], c = src[1];
      *(uint4*)(T + pos * 72 + seg) = a; *(uint4*)(T + pos * 72 + seg + 8) = c; }
    __syncthreads();
    { const int dim = tid >> 2, ps = (tid & 3) * 16;
      unsigned w[8];
#pragma unroll
      for (int q = 0; q < 8; ++q) w[q] = (unsigned)T[(ps + 2 * q) * 72 + dim] | ((unsigned)T[(ps + 2 * q + 1) * 72 + dim] << 16);
      uint4* dst = (uint4*)(P.vt + ((size_t)((type * 8 + b) * 2 + kvh) * 64 + dim) * VT_LD + pt * 64 + ps);
      dst[0] = make_uint4(w[0], w[1], w[2], w[3]); dst[1] = make_uint4(w[4], w[5], w[6], w[7]); }
    __syncthreads();
}
__device__ void qkprep_rows(const Params& P, int layer, int row, int lane) {
    const bool lat = row < ML;
    const int t = lat ? (row & (SEQ - 1)) : 0;
    const int i = lane & 31;
    float cs = 1.f, sn = 0.f;
    if (lat) { const int fi = i & 15; const float invf = exp2f(-(float)fi * (13.287712379549449f / 16.f)); const float pos = (i < 16) ? (float)(t >> 6) : (float)(t & 63);
        const float ang = pos * invf; cs = __cosf(ang); sn = __sinf(ang); }
    bf16_t* pr = P.p + (size_t)row * INW;
    const float qs = 0.125f * 1.4426950408889634f;
#pragma unroll
    for (int it = 0; it < 6; ++it) {
        const int slot = it * 2 + (lane >> 5);
        int col; float scl = 1.f; const float* gain = nullptr;
        if (slot < 4) { col = P_AQ + slot * 64; gain = P.attn_q_norm + layer * 64; scl = qs; }
        else if (slot < 6) { col = P_AK + (slot - 4) * 64; gain = P.attn_k_norm + layer * 64; }
        else if (slot < 10) { col = P_WQ + (slot - 6) * 64; scl = qs; }
        else col = P_WK + (slot - 10) * 64;
        unsigned* ptr = (unsigned*)(pr + col + 2 * i);
        const unsigned u = *ptr;
        float x0 = __uint_as_float(u << 16), x1 = __uint_as_float(u & 0xffff0000u);
        if (slot < 6) {
            float ss = x0 * x0 + x1 * x1;
#pragma unroll
            for (int o = 16; o >= 1; o >>= 1) ss += __shfl_xor(ss, o);
            const float rstd = rsqrtf(ss * (1.f / 64.f) + EPS);
            x0 = x0 * rstd * gain[2 * i]; x1 = x1 * rstd * gain[2 * i + 1];
        }
        const float y0 = (x0 * cs - x1 * sn) * scl, y1 = (x0 * sn + x1 * cs) * scl;
        *ptr = cvt_pk_bf16(y0, y1);
    }
}


__device__ __forceinline__ void gdnprep_row(const Params& P, int layer, int row, int lane, const float (&cwr)[24]) {
    const bool lat = row < ML; const int s0 = lat ? (row & ~(SEQ - 1)) : (ML + ((row - ML) & ~(CTX - 1))), L = lat ? SEQ : CTX, t = row - s0;
    const int seg = lane >> 5, c0 = (lane & 31) * 8, pcol = (seg ? P_GK : P_GQ) + c0;
    float x0[8], x1[8], x2[8];
    const u32x4 z4 = {0u, 0u, 0u, 0u};
    unpack8(t > 0 ? *(const u32x4*)(P.p + (size_t)(row - 1) * INW + pcol) : z4, x0);
    unpack8(*(const u32x4*)(P.p + (size_t)row * INW + pcol), x1);
    unpack8(t + 1 < L ? *(const u32x4*)(P.p + (size_t)(row + 1) * INW + pcol) : z4, x2);
    float y[8], ss = 0.f;
#pragma unroll
    for (int q = 0; q < 8; ++q) { const float v = silu_f(cwr[q] * x0[q] + cwr[8 + q] * x1[q] + cwr[16 + q] * x2[q]); y[q] = v; ss += v * v; }
    ss = red8(ss);
    const float sc = rsqrtf(ss + EPS) * (seg == 0 ? 0.125f : 1.f);
    const u32x4 pk = {cvt_pk_bf16(y[0] * sc, y[1] * sc), cvt_pk_bf16(y[2] * sc, y[3] * sc), cvt_pk_bf16(y[4] * sc, y[5] * sc), cvt_pk_bf16(y[6] * sc, y[7] * sc)};
    *(u32x4*)(P.gqk + (size_t)row * 512 + lane * 8) = pk;
}

__device__ void attn_item(const Params& P, int layer, int type, int b, int kvh, int qt, bool is_ctx, char* lds) {
    const int tid = opaque_tid(), w = tid >> 6, lane = tid & 63, lr = lane & 15, quad = lane >> 4;
    const bf16_t* pp = P.p;
    const int qcol = (type ? P_WQ : P_AQ) + kvh * 128, kcol = (type ? P_WK : P_AK) + kvh * 64;
    const int qrow0 = is_ctx ? (ML + b * CTX + qt * 64) : (b * SEQ + qt * 64);
    const int myq = qrow0 + w * 16 + lr;
    bf16x8 qf[2][2];
#pragma unroll
    for (int g = 0; g < 2; ++g)
#pragma unroll
        for (int ks = 0; ks < 2; ++ks) qf[g][ks] = *(const bf16x8*)(pp + (size_t)myq * INW + qcol + g * 64 + ks * 32 + quad * 8);
    int lt0 = 0, nlat = 0;
    if (!is_ctx) { if (type == 0) { lt0 = 0; nlat = 32; } else { lt0 = max(0, qt - 2); nlat = min(31, qt + 2) - lt0 + 1; } }
    const int nt = 4 + nlat;
    const bf16_t* vbase = P.vt + (size_t)((type * 8 + b) * 2 + kvh) * 64 * VT_LD;
    char* Ks = lds; char* Vs = lds + 8192;
    const int sr = tid >> 3, sc = tid & 7;
    const int swr = sr * 128 + ((sc ^ (sr & 7)) * 16);
    float m[2], l[2]; f32x4 o[2][4];
#pragma unroll
    for (int g = 0; g < 2; ++g) {
        if (type == 1) { m[g] = P.swa_sink[layer * 4 + kvh * 2 + g] * 1.4426950408889634f; l[g] = (quad == 0) ? 1.f : 0.f; } else { m[g] = -1e30f; l[g] = 0.f; }
#pragma unroll
        for (int db = 0; db < 4; ++db) o[g][db] = (f32x4){0.f, 0.f, 0.f, 0.f};
    }
    u32x4 rk[2], rv[2];
    auto issue = [&](int ti) {
        const int krow0 = (ti < 4) ? (ML + b * CTX + ti * 64) : (b * SEQ + (lt0 + ti - 4) * 64);
        const int pos0 = (ti < 4) ? ti * 64 : 256 + (lt0 + ti - 4) * 64;
#pragma unroll
        for (int i = 0; i < 2; ++i) { rk[i] = *(const u32x4*)(pp + (size_t)(krow0 + sr + 32 * i) * INW + kcol + sc * 8);
            rv[i] = *(const u32x4*)(vbase + (size_t)(sr + 32 * i) * VT_LD + pos0 + sc * 8); }
    };
    issue(0);
    const int qp = qt * 64 + w * 16 + lr;
    for (int ti = 0; ti < nt; ++ti) {
        __syncthreads();
#pragma unroll
        for (int i = 0; i < 2; ++i) { *(u32x4*)(Ks + swr + i * 4096) = rk[i]; *(u32x4*)(Vs + swr + i * 4096) = rv[i]; }
        __syncthreads();
        if (ti + 1 < nt) issue(ti + 1);
        f32x4 s[2][4];
#pragma unroll
        for (int g = 0; g < 2; ++g)
#pragma unroll
            for (int kb = 0; kb < 4; ++kb) s[g][kb] = (f32x4){0.f, 0.f, 0.f, 0.f};
#pragma unroll
        for (int ks = 0; ks < 2; ++ks)
#pragma unroll
            for (int kb = 0; kb < 4; ++kb) { const int r = kb * 16 + lr; const int ch = ks * 4 + quad;
                const bf16x8 kf = *(const bf16x8*)(Ks + r * 128 + ((ch ^ (r & 7)) * 16));
#pragma unroll
                for (int g = 0; g < 2; ++g) s[g][kb] = __builtin_amdgcn_mfma_f32_16x16x32_bf16(kf, qf[g][ks], s[g][kb], 0, 0, 0); }
        if (type == 1 && ti >= 4) {
            const int kp0 = (lt0 + ti - 4) * 64 + quad * 4;
#pragma unroll
            for (int kb = 0; kb < 4; ++kb)
#pragma unroll
                for (int j = 0; j < 4; ++j) { const int dlt = qp - (kp0 + kb * 16 + j); const bool ok = (dlt <= 128) && (dlt >= -128);
#pragma unroll
                    for (int g = 0; g < 2; ++g) s[g][kb][j] = ok ? s[g][kb][j] : -1e30f; }
        }
        bf16x8 pf[2][2];
#pragma unroll
        for (int g = 0; g < 2; ++g) {
            float mx = -1e30f;
#pragma unroll
            for (int kb = 0; kb < 4; ++kb) mx = fmaxf(mx, fmaxf(fmaxf(s[g][kb][0], s[g][kb][1]), fmaxf(s[g][kb][2], s[g][kb][3])));
            mx = fmaxf(mx, __shfl_xor(mx, 16)); mx = fmaxf(mx, __shfl_xor(mx, 32));
            const float mn = fmaxf(m[g], mx); const float alpha = exp2f(m[g] - mn); m[g] = mn;
            float ps = 0.f;
#pragma unroll
            for (int kb = 0; kb < 4; ++kb)
#pragma unroll
                for (int j = 0; j < 4; ++j) { const float e = exp2f(s[g][kb][j] - mn); s[g][kb][j] = e; ps += e; }
            l[g] = l[g] * alpha + ps;
#pragma unroll
            for (int db = 0; db < 4; ++db) o[g][db] *= alpha;
#pragma unroll
            for (int ks = 0; ks < 2; ++ks) {
                u32x4 pk;
                pk[0] = cvt_pk_bf16(s[g][2 * ks][0], s[g][2 * ks][1]); pk[1] = cvt_pk_bf16(s[g][2 * ks][2], s[g][2 * ks][3]);
                pk[2] = cvt_pk_bf16(s[g][2 * ks + 1][0], s[g][2 * ks + 1][1]); pk[3] = cvt_pk_bf16(s[g][2 * ks + 1][2], s[g][2 * ks + 1][3]);
                pf[g][ks] = __builtin_bit_cast(bf16x8, pk);
            }
        }
#pragma unroll
        for (int ks = 0; ks < 2; ++ks)
#pragma unroll
            for (int db = 0; db < 4; ++db) { const int dim = db * 16 + lr; const int c1 = ks * 4 + (quad >> 1), c2 = c1 + 2;
                const uint2 h0 = *(const uint2*)(Vs + dim * 128 + ((c1 ^ (dim & 7)) * 16) + (quad & 1) * 8);
                const uint2 h1 = *(const uint2*)(Vs + dim * 128 + ((c2 ^ (dim & 7)) * 16) + (quad & 1) * 8);
                const bf16x8 vfv = __builtin_bit_cast(bf16x8, (u32x4){h0.x, h0.y, h1.x, h1.y});
#pragma unroll
                for (int g = 0; g < 2; ++g) o[g][db] = __builtin_amdgcn_mfma_f32_16x16x32_bf16(vfv, pf[g][ks], o[g][db], 0, 0, 0); }
    }
    const int mixcol = (type ? 512 : 256) + kvh * 128;
#pragma unroll
    for (int g = 0; g < 2; ++g) {
        float lt = l[g]; lt += __shfl_xor(lt, 16); lt += __shfl_xor(lt, 32);
        const float inv = 1.f / lt;
#pragma unroll
        for (int db = 0; db < 4; ++db) { uint2 ov; ov.x = cvt_pk_bf16(o[g][db][0] * inv, o[g][db][1] * inv); ov.y = cvt_pk_bf16(o[g][db][2] * inv, o[g][db][3] * inv);
            *(uint2*)(P.hm + (size_t)myq * D + mixcol + g * 64 + db * 16 + quad * 4) = ov; }
    }
    __syncthreads();
}

constexpr int TCH = 32;

typedef short bf16x4 __attribute__((ext_vector_type(4)));
typedef unsigned u32x2 __attribute__((ext_vector_type(2)));
__device__ __forceinline__ bf16x4 pack4(f32x4 v) { const u32x2 u = {cvt_pk_bf16(v[0], v[1]), cvt_pk_bf16(v[2], v[3])}; return __builtin_bit_cast(bf16x4, u); }
__device__ __forceinline__ f32x4 unpack4(u32x2 u) { return (f32x4){__uint_as_float(u[0] << 16), __uint_as_float(u[0] & 0xffff0000u), __uint_as_float(u[1] << 16), __uint_as_float(u[1] & 0xffff0000u)}; }
__device__ void gdn_chunked(const Params& P, int layer, int item, char* lds) {
    __builtin_amdgcn_s_setprio(3);
    const int tid0 = opaque_tid(), w = __builtin_amdgcn_readfirstlane(tid0 >> 6);
    const int dir = item & 1, h = (item >> 1) & 3, b = item >> 3;
    constexpr int TSE = 64 * 72;
    bf16_t* St = (bf16_t*)lds;
    bf16_t* Kh = St + TSE;
    bf16_t* Qh = Kh + TSE;
    bf16_t* Vt = Qh + TSE;
    bf16_t* Kdt = Vt + TSE;
    bf16_t* nM = Kdt + TSE;
    bf16_t* At = nM + TSE;
    bf16_t* raw = nM;
    float* cw = (float*)(lds + 59136);
    float* gsc = (float*)(lds + 64512);
    const float neg_ea = -__expf(P.gdn_a_log[layer * 8 + dir * 4 + h]);
    const float dtb = P.gdn_dt_bias[layer * 8 + dir * 4 + h];
    f32x4 Sreg[4];
#pragma unroll
    for (int nb = 0; nb < 4; ++nb) Sreg[nb] = (f32x4){0.f, 0.f, 0.f, 0.f};
    for (int i = tid0; i < TSE / 2; i += 256) ((unsigned*)St)[i] = 0u;
    u32x4 preqk[4], prev[3]; unsigned pab = 0;
    int tid = tid0;
    const float cwreg = (tid0 < 192) ? P.gdn_conv_w[(size_t)layer * 3 * 768 + (tid0 >> 6) * 768 + 512 + h * 64 + (tid0 & 63)] : 0.f;
    bf16_t* rawv = nM;
    float* cwv = (float*)(lds + 59136);
    auto chunk_info = [&](int ci, int& sbase, int& L, int& t0c, bool& isctx) {
        isctx = ci < 4; const int n = isctx ? 4 : 32; int cj = isctx ? ci : ci - 4; if (dir) cj = n - 1 - cj;
        sbase = isctx ? (ML + b * CTX) : (b * SEQ); L = isctx ? CTX : SEQ; t0c = cj * 64;
    };
    auto issue = [&](int ci) {
        int sbase, L, t0c; bool isctx; chunk_info(ci, sbase, L, t0c, isctx);
#pragma unroll
        for (int i = 0; i < 4; ++i) { const int idx = tid + 256 * i; const int row = idx >> 4, part = idx & 15; const int trow = t0c + (dir ? 63 - row : row);
            const int col = (part < 8) ? h * 64 + part * 8 : 256 + h * 64 + (part - 8) * 8;
            preqk[i] = *(const u32x4*)(P.gqk + (size_t)(sbase + trow) * 512 + col); }
#pragma unroll
        for (int i = 0; i < 3; ++i) { const int idx = tid + 256 * i; const int rr = idx >> 3, ch = idx & 7; const int tr = t0c - 1 + rr;
            if (idx < 528 && tr >= 0 && tr < L) prev[i] = *(const u32x4*)(P.p + (size_t)(sbase + tr) * INW + P_GV + h * 64 + ch * 8); else prev[i] = (u32x4){0u, 0u, 0u, 0u}; }
        if (tid < 64) { const bf16_t* pr = P.p + (size_t)(sbase + t0c + tid) * INW; pab = (unsigned)pr[P_BETA + dir * 4 + h] | ((unsigned)pr[P_A + dir * 4 + h] << 16); }
    };
    issue(0);
    for (int ci = 0; ci < 36; ++ci) {
        asm volatile("" : "+v"(tid));
        const int lane = tid & 63, lr = lane & 15, quad = lane >> 4;
        int sbase = 0, L = 0, t0c = 0; bool isctx = false;
        chunk_info(ci, sbase, L, t0c, isctx);
        __syncthreads();
#pragma unroll
        for (int i = 0; i < 4; ++i) { const int idx = tid + 256 * i; const int row = idx >> 4, part = idx & 15;
            if (part < 8) *(u32x4*)(Qh + row * 72 + part * 8) = preqk[i]; else *(u32x4*)(Kh + row * 72 + (part - 8) * 8) = preqk[i]; }
#pragma unroll
        for (int i = 0; i < 3; ++i) { const int idx = tid + 256 * i; if (idx < 528) *(u32x4*)(rawv + idx * 8) = prev[i]; }
        if (tid < 192) cwv[tid] = cwreg;
        if (tid < 64) { const int i = dir ? 63 - tid : tid;
            const float braw = __uint_as_float(pab << 16), araw = __uint_as_float(pab & 0xffff0000u);
            const float av = araw + dtb; const float sp = (av > 20.f) ? av : __logf(1.f + __expf(av));
            float g = neg_ea * sp; gsc[i] = g; gsc[128 + i] = sigmoid_f(braw);
#pragma unroll
            for (int o = 1; o < 64; o <<= 1) { const float t = dir ? __shfl_down(g, o) : __shfl_up(g, o); if (dir ? (tid + o < 64) : (tid >= o)) g += t; }
            gsc[64 + i] = g; gsc[192 + i] = __expf(g); }
        __syncthreads();
        if (ci + 1 < 36) issue(ci + 1);
        { const int rg = tid >> 2, c0 = (tid & 3) * 16, i = dir ? 63 - rg : rg;
#pragma unroll
          for (int hf = 0; hf < 2; ++hf) { float x0[8], x1[8], x2[8], yv[8];
              unpack8(*(const u32x4*)(rawv + rg * 64 + c0 + hf * 8), x0); unpack8(*(const u32x4*)(rawv + (rg + 1) * 64 + c0 + hf * 8), x1); unpack8(*(const u32x4*)(rawv + (rg + 2) * 64 + c0 + hf * 8), x2);
#pragma unroll
              for (int q = 0; q < 8; ++q) { const int c = c0 + hf * 8 + q; yv[q] = silu_f(cwv[c] * x0[q] + cwv[64 + c] * x1[q] + cwv[128 + c] * x2[q]); }
              *(u32x4*)(Vt + i * 72 + c0 + hf * 8) = (u32x4){cvt_pk_bf16(yv[0], yv[1]), cvt_pk_bf16(yv[2], yv[3]), cvt_pk_bf16(yv[4], yv[5]), cvt_pk_bf16(yv[6], yv[7])}; } }
        __syncthreads();
        const float gc_last = gsc[64 + 63], g_last = gsc[192 + 63];
        { const int i = tid >> 2, part = tid & 3; const float sc = __expf(gc_last - gsc[64 + i]);
          float kv[16]; unpack8(*(const u32x4*)(Kh + i * 72 + part * 16), kv); unpack8(*(const u32x4*)(Kh + i * 72 + part * 16 + 8), kv + 8);
#pragma unroll
          for (int q = 0; q < 16; ++q) Kdt[(part * 16 + q) * 72 + i] = f2bf(kv[q] * sc); }
        {
            f32x4 kk[4], qk[4];
#pragma unroll
            for (int nb = 0; nb < 4; ++nb) { kk[nb] = (f32x4){0.f, 0.f, 0.f, 0.f}; qk[nb] = (f32x4){0.f, 0.f, 0.f, 0.f}; }
#pragma unroll
            for (int ks = 0; ks < 2; ++ks) {
                const bf16x8 ak = *(const bf16x8*)(Kh + (16 * w + lr) * 72 + ks * 32 + quad * 8), aq = *(const bf16x8*)(Qh + (16 * w + lr) * 72 + ks * 32 + quad * 8);
#pragma unroll
                for (int nb = 0; nb < 4; ++nb) if (nb <= w) { const bf16x8 bj = *(const bf16x8*)(Kh + (16 * nb + lr) * 72 + ks * 32 + quad * 8);
                    kk[nb] = __builtin_amdgcn_mfma_f32_16x16x32_bf16(bj, ak, kk[nb], 0, 0, 0); qk[nb] = __builtin_amdgcn_mfma_f32_16x16x32_bf16(bj, aq, qk[nb], 0, 0, 0); }
            }
            const int i = 16 * w + lr; const float gci = gsc[64 + i], bi = gsc[128 + i];
#pragma unroll
            for (int nb = 0; nb < 4; ++nb) { f32x4 mv, av;
#pragma unroll
                for (int jj = 0; jj < 4; ++jj) { const int j = 16 * nb + quad * 4 + jj; const float dec = (i >= j) ? __expf(gci - gsc[64 + j]) : 0.f;
                    mv[jj] = (i > j) ? -bi * kk[nb][jj] * dec : 0.f; av[jj] = qk[nb][jj] * dec; }
                *(u32x2*)(nM + i * 72 + 16 * nb + quad * 4) = (u32x2){cvt_pk_bf16(mv[0], mv[1]), cvt_pk_bf16(mv[2], mv[3])};
                *(u32x2*)(At + i * 72 + 16 * nb + quad * 4) = (u32x2){cvt_pk_bf16(av[0], av[1]), cvt_pk_bf16(av[2], av[3])}; }
        }
        __syncthreads();
        {
            const bf16x4 nf = __builtin_bit_cast(bf16x4, *(const u32x2*)(nM + (16 * w + lr) * 72 + 16 * w + quad * 4));
            f32x4 pw, sum;
#pragma unroll
            for (int jj = 0; jj < 4; ++jj) { pw[jj] = bf2f(nM[(16 * w + quad * 4 + jj) * 72 + 16 * w + lr]); sum[jj] = pw[jj] + ((quad * 4 + jj == lr) ? 1.f : 0.f); }
#pragma unroll
            for (int k = 2; k < 16; ++k) { pw = __builtin_amdgcn_mfma_f32_16x16x16bf16_1k(nf, pack4(pw), (f32x4){0.f, 0.f, 0.f, 0.f}, 0, 0, 0); sum += pw; }
#pragma unroll
            for (int jj = 0; jj < 4; ++jj) nM[(16 * w + quad * 4 + jj) * 72 + 16 * w + lr] = f2bf(sum[jj]);
        }
        f32x4 X[4][2];
#pragma unroll
        for (int bb = 0; bb < 4; ++bb)
#pragma unroll
            for (int nb = 0; nb < 2; ++nb)
#pragma unroll
                for (int jj = 0; jj < 4; ++jj) { const int i = 16 * bb + quad * 4 + jj; const int n = 32 * (w & 1) + 16 * nb + lr;
                    X[bb][nb][jj] = (w < 2) ? gsc[128 + i] * bf2f(Vt[i * 72 + n]) : gsc[128 + i] * gsc[192 + i] * bf2f(Kh[i * 72 + n]); }
        __syncthreads();
        {
            bf16x4 Xb[4][2];
#pragma unroll
            for (int bb = 0; bb < 4; ++bb) {
#pragma unroll
                for (int bp = 0; bp < bb; ++bp) { const bf16x4 lf = __builtin_bit_cast(bf16x4, *(const u32x2*)(nM + (16 * bb + lr) * 72 + 16 * bp + quad * 4));
#pragma unroll
                    for (int nb = 0; nb < 2; ++nb) X[bb][nb] = __builtin_amdgcn_mfma_f32_16x16x16bf16_1k(lf, Xb[bp][nb], X[bb][nb], 0, 0, 0); }
                const bf16x4 df = __builtin_bit_cast(bf16x4, *(const u32x2*)(nM + (16 * bb + lr) * 72 + 16 * bb + quad * 4));
#pragma unroll
                for (int nb = 0; nb < 2; ++nb) { const bf16x4 zb = pack4(X[bb][nb]);
                    X[bb][nb] = __builtin_amdgcn_mfma_f32_16x16x16bf16_1k(df, zb, (f32x4){0.f, 0.f, 0.f, 0.f}, 0, 0, 0); Xb[bb][nb] = pack4(X[bb][nb]); }
            }
#pragma unroll
            for (int bb = 0; bb < 4; ++bb)
#pragma unroll
                for (int nb = 0; nb < 2; ++nb) { const int n = 32 * (w & 1) + 16 * nb + lr, i0 = 16 * bb + quad * 4;
                    if (w < 2) *(u32x2*)(Vt + n * 72 + i0) = __builtin_bit_cast(u32x2, Xb[bb][nb]);
                    else {
#pragma unroll
                        for (int jj = 0; jj < 4; ++jj) Kh[(i0 + jj) * 72 + n] = (bf16_t)Xb[bb][nb][jj]; } }
        }
        __syncthreads();
        {
            f32x4 acc[4];
#pragma unroll
            for (int nb = 0; nb < 4; ++nb) acc[nb] = (f32x4){0.f, 0.f, 0.f, 0.f};
#pragma unroll
            for (int ks = 0; ks < 2; ++ks) { const bf16x8 se = *(const bf16x8*)(St + (16 * w + lr) * 72 + ks * 32 + quad * 8);
#pragma unroll
                for (int nb = 0; nb < 4; ++nb) { const bf16x8 wi = *(const bf16x8*)(Kh + (16 * nb + lr) * 72 + ks * 32 + quad * 8);
                    acc[nb] = __builtin_amdgcn_mfma_f32_16x16x32_bf16(wi, se, acc[nb], 0, 0, 0); } }
            const int e = 16 * w + lr;
            f32x4 vn[4];
#pragma unroll
            for (int nb = 0; nb < 4; ++nb) vn[nb] = unpack4(*(const u32x2*)(Vt + e * 72 + 16 * nb + quad * 4)) - acc[nb];
            __syncthreads();
#pragma unroll
            for (int nb = 0; nb < 4; ++nb) *(u32x2*)(nM + e * 72 + 16 * nb + quad * 4) = (u32x2){cvt_pk_bf16(vn[nb][0], vn[nb][1]), cvt_pk_bf16(vn[nb][2], vn[nb][3])};
        }
        __syncthreads();
        {
            f32x4 o1[4], o2[4], sa[4];
#pragma unroll
            for (int nb = 0; nb < 4; ++nb) { o1[nb] = (f32x4){0.f, 0.f, 0.f, 0.f}; o2[nb] = (f32x4){0.f, 0.f, 0.f, 0.f}; sa[nb] = (f32x4){0.f, 0.f, 0.f, 0.f}; }
#pragma unroll
            for (int ks = 0; ks < 2; ++ks) {
                const bf16x8 bq = *(const bf16x8*)(Qh + (16 * w + lr) * 72 + ks * 32 + quad * 8), ba = *(const bf16x8*)(At + (16 * w + lr) * 72 + ks * 32 + quad * 8);
                const bf16x8 bv = *(const bf16x8*)(nM + (16 * w + lr) * 72 + ks * 32 + quad * 8);
#pragma unroll
                for (int nb = 0; nb < 4; ++nb) {
                    const bf16x8 as_ = *(const bf16x8*)(St + (16 * nb + lr) * 72 + ks * 32 + quad * 8), av = *(const bf16x8*)(nM + (16 * nb + lr) * 72 + ks * 32 + quad * 8);
                    const bf16x8 ak = *(const bf16x8*)(Kdt + (16 * nb + lr) * 72 + ks * 32 + quad * 8);
                    o1[nb] = __builtin_amdgcn_mfma_f32_16x16x32_bf16(as_, bq, o1[nb], 0, 0, 0);
                    o2[nb] = __builtin_amdgcn_mfma_f32_16x16x32_bf16(av, ba, o2[nb], 0, 0, 0);
                    sa[nb] = __builtin_amdgcn_mfma_f32_16x16x32_bf16(ak, bv, sa[nb], 0, 0, 0);
                }
            }
            { const int i = 16 * w + lr; const float eg = gsc[192 + i]; const int t = t0c + (dir ? 63 - i : i);
                bf16_t* orow = P.r2 + ((size_t)(0 * 2 + dir) * MT + sbase + t) * 256 + h * 64;
#pragma unroll
                for (int nb = 0; nb < 4; ++nb) { const f32x4 ov = o1[nb] * eg + o2[nb];
                    *(u32x2*)(orow + 16 * nb + quad * 4) = (u32x2){cvt_pk_bf16(ov[0], ov[1]), cvt_pk_bf16(ov[2], ov[3])}; } }
#pragma unroll
            for (int nb = 0; nb < 4; ++nb) Sreg[nb] = Sreg[nb] * g_last + sa[nb];
            __syncthreads();
            const int e = 16 * w + lr;
#pragma unroll
            for (int nb = 0; nb < 4; ++nb) *(u32x2*)(St + e * 72 + 16 * nb + quad * 4) = (u32x2){cvt_pk_bf16(Sreg[nb][0], Sreg[nb][1]), cvt_pk_bf16(Sreg[nb][2], Sreg[nb][3])};
        }
    }
    __syncthreads();
    __builtin_amdgcn_s_setprio(0);
}

__device__ void hgrn_chunked(const Params& P, int layer, int item, char* lds) {
    const int tid0 = opaque_tid(), w = __builtin_amdgcn_readfirstlane(tid0 >> 6);
    const int dir = item & 1, h = (item >> 1) & 3, b = item >> 3;
    constexpr int TSE = 64 * 72;
    bf16_t* qraw = (bf16_t*)lds;
    bf16_t* zraw = qraw + 4096;
    bf16_t* Qt = zraw + 4096;
    bf16_t* Kt = Qt + TSE;
    bf16_t* Qs = Kt + TSE;
    bf16_t* KdT = Qs + TSE;
    bf16_t* VT = KdT + TSE;
    float* gt = (float*)(VT + TSE);
    bf16_t* Ab = qraw;
    float lb;
    { const int d = tid0 & 63; const float r0 = P.hgrn_lb_raw[(0 * 2 + dir) * 256 + h * 64 + d], r1 = P.hgrn_lb_raw[(1 * 2 + dir) * 256 + h * 64 + d];
      const float mx = fmaxf(r0, r1), e0 = __expf(r0 - mx), e1 = __expf(r1 - mx); lb = (layer == 0) ? 0.f : e1 / (e0 + e1); }
    f32x4 Sreg[4];
#pragma unroll
    for (int nb = 0; nb < 4; ++nb) Sreg[nb] = (f32x4){0.f, 0.f, 0.f, 0.f};
    u32x4 pre[6];
    int tid = tid0;
    auto chunk_info = [&](int ci, int& sbase, int& t0c, bool& isctx) {
        isctx = ci < 4; const int n = isctx ? 4 : 32; int cj = isctx ? ci : ci - 4; if (dir) cj = n - 1 - cj;
        sbase = isctx ? (ML + b * CTX) : (b * SEQ); t0c = cj * 64;
    };
    auto issue = [&](int ci) {
        int sbase, t0c; bool isctx; chunk_info(ci, sbase, t0c, isctx);
#pragma unroll
        for (int i = 0; i < 6; ++i) { const int idx = tid + 256 * i; const int row = idx / 24, rem = idx % 24, seg = rem >> 3, ch = rem & 7;
            const int col = (seg == 0 ? P_HQ : (seg == 1 ? P_HF + dir * 256 : P_HI)) + h * 64 + ch * 8; const int trow = t0c + (dir ? 63 - row : row);
            pre[i] = *(const u32x4*)(P.p + (size_t)(sbase + trow) * INW + col); }
    };
    issue(0);
    for (int ci = 0; ci < 36; ++ci) {
        asm volatile("" : "+v"(tid));
        const int lane = tid & 63, lr = lane & 15, quad = lane >> 4;
        int sbase, t0c; bool isctx; chunk_info(ci, sbase, t0c, isctx);
        __syncthreads();
#pragma unroll
        for (int i = 0; i < 6; ++i) { const int idx = tid + 256 * i; const int row = idx / 24, rem = idx % 24, seg = rem >> 3, ch = rem & 7;
            if (seg == 0) *(u32x4*)(qraw + row * 64 + ch * 8) = pre[i];
            else if (seg == 1) *(u32x4*)(zraw + row * 64 + ch * 8) = pre[i];
            else {
#pragma unroll
                for (int q = 0; q < 4; ++q) { VT[(ch * 8 + 2 * q) * 72 + row] = (bf16_t)(pre[i][q] & 0xffffu); VT[(ch * 8 + 2 * q + 1) * 72 + row] = (bf16_t)(pre[i][q] >> 16); } } }
        __syncthreads();
        if (ci + 1 < 36) issue(ci + 1);
        { const int d = tid & 63, sc = tid >> 6;
          float bcv[16], qv[16], kv[16]; float c = 0.f;
#pragma unroll
          for (int r = 0; r < 16; ++r) { const int i = 16 * sc + r; float z = bf2f(zraw[i * 64 + d]); z = fminf(fmaxf(z, -30.f), 30.f);
              const float ez = __expf(-z), sg = __builtin_amdgcn_rcpf(1.f + ez); const float f = lb + (1.f - lb) * sg;
              c += __logf(f); bcv[r] = c; kv[r] = (1.f - lb) * ez * sg; qv[r] = silu_f(bf2f(qraw[i * 64 + d])); }
          const float m = bcv[7], last = c, em = __expf(m), elm = __expf(last - m);
          float kd[16];
#pragma unroll
          for (int r = 0; r < 16; ++r) { const int i = 16 * sc + r; const float E1 = __expf(bcv[r] - m), E2 = __expf(m - bcv[r]);
              const float q1 = qv[r] * E1, k2 = kv[r] * E2;
              Qt[i * 72 + d] = f2bf(q1); Kt[i * 72 + d] = f2bf(k2); Qs[i * 72 + d] = f2bf(q1 * em); kd[r] = k2 * elm; }
          *(u32x4*)(KdT + d * 72 + 16 * sc) = (u32x4){cvt_pk_bf16(kd[0], kd[1]), cvt_pk_bf16(kd[2], kd[3]), cvt_pk_bf16(kd[4], kd[5]), cvt_pk_bf16(kd[6], kd[7])};
          *(u32x4*)(KdT + d * 72 + 16 * sc + 8) = (u32x4){cvt_pk_bf16(kd[8], kd[9]), cvt_pk_bf16(kd[10], kd[11]), cvt_pk_bf16(kd[12], kd[13]), cvt_pk_bf16(kd[14], kd[15])};
          gt[sc * 64 + d] = __expf(last); }
        __syncthreads();
        { f32x4 a = (f32x4){0.f, 0.f, 0.f, 0.f};
#pragma unroll
          for (int ks = 0; ks < 2; ++ks) { const bf16x8 kj = *(const bf16x8*)(Kt + (16 * w + lr) * 72 + ks * 32 + quad * 8), qi = *(const bf16x8*)(Qt + (16 * w + lr) * 72 + ks * 32 + quad * 8);
              a = __builtin_amdgcn_mfma_f32_16x16x32_bf16(kj, qi, a, 0, 0, 0); }
#pragma unroll
          for (int jj = 0; jj < 4; ++jj) if (quad * 4 + jj > lr) a[jj] = 0.f;
          *(u32x2*)(Ab + (16 * w + lr) * 24 + quad * 4) = (u32x2){cvt_pk_bf16(a[0], a[1]), cvt_pk_bf16(a[2], a[3])}; }
        __syncthreads();
#pragma unroll 1
        for (int sc = 0; sc < 4; ++sc) {
            f32x4 o = (f32x4){0.f, 0.f, 0.f, 0.f};
#pragma unroll
            for (int ks = 0; ks < 2; ++ks) {
                const u32x2 s0 = __builtin_bit_cast(u32x2, pack4(Sreg[2 * ks])), s1 = __builtin_bit_cast(u32x2, pack4(Sreg[2 * ks + 1]));
                const bf16x8 sa = __builtin_bit_cast(bf16x8, (u32x4){s0[0], s0[1], s1[0], s1[1]});
                const u32x2 q0 = *(const u32x2*)(Qs + (16 * sc + lr) * 72 + 32 * ks + 4 * quad), q1 = *(const u32x2*)(Qs + (16 * sc + lr) * 72 + 32 * ks + 16 + 4 * quad);
                const bf16x8 qb = __builtin_bit_cast(bf16x8, (u32x4){q0[0], q0[1], q1[0], q1[1]});
                o = __builtin_amdgcn_mfma_f32_16x16x32_bf16(sa, qb, o, 0, 0, 0);
            }
            const bf16x4 vt = __builtin_bit_cast(bf16x4, *(const u32x2*)(VT + (16 * w + lr) * 72 + 16 * sc + quad * 4));
            const bf16x4 ab = __builtin_bit_cast(bf16x4, *(const u32x2*)(Ab + (16 * sc + lr) * 24 + quad * 4));
            o = __builtin_amdgcn_mfma_f32_16x16x16bf16_1k(vt, ab, o, 0, 0, 0);
            { const int i = 16 * sc + lr; const int t = t0c + (dir ? 63 - i : i);
                *(u32x2*)(P.r2 + ((size_t)(1 * 2 + dir) * MT + sbase + t) * 256 + h * 64 + 16 * w + quad * 4) = (u32x2){cvt_pk_bf16(o[0], o[1]), cvt_pk_bf16(o[2], o[3])}; }
#pragma unroll
            for (int nb = 0; nb < 4; ++nb) {
                const bf16x4 kf = __builtin_bit_cast(bf16x4, *(const u32x2*)(KdT + (16 * nb + lr) * 72 + 16 * sc + quad * 4));
                const f32x4 upd = __builtin_amdgcn_mfma_f32_16x16x16bf16_1k(kf, vt, (f32x4){0.f, 0.f, 0.f, 0.f}, 0, 0, 0);
                const f32x4 gv = *(const f32x4*)(gt + sc * 64 + 16 * nb + quad * 4);
                Sreg[nb] = Sreg[nb] * gv + upd;
            }
        }
    }
    __syncthreads();
}

__device__ void scanfin_row(const Params& P, int layer, int row, int lane) {
    const int hcol = lane * 4;
#pragma unroll
    for (int mx = 0; mx < 2; ++mx) {
        const uint2 uf = *(const uint2*)(P.r2 + ((size_t)(mx * 2 + 0) * MT + row) * 256 + hcol), ub = *(const uint2*)(P.r2 + ((size_t)(mx * 2 + 1) * MT + row) * 256 + hcol);
        float o[4];
        o[0] = __uint_as_float(uf.x << 16) + __uint_as_float(ub.x << 16); o[1] = __uint_as_float(uf.x & 0xffff0000u) + __uint_as_float(ub.x & 0xffff0000u);
        o[2] = __uint_as_float(uf.y << 16) + __uint_as_float(ub.y << 16); o[3] = __uint_as_float(uf.y & 0xffff0000u) + __uint_as_float(ub.y & 0xffff0000u);
        float ss = o[0] * o[0] + o[1] * o[1] + o[2] * o[2] + o[3] * o[3];
#pragma unroll
        for (int k = 8; k >= 1; k >>= 1) ss += __shfl_xor(ss, k);
        const float rstd = rsqrtf(ss * (1.f / 64.f) + EPS);
        const float* gain = (mx ? P.hgrn_norm : P.gdn_norm) + layer * 64 + (hcol & 63);
        const uint2 ug = *(const uint2*)(P.p + (size_t)row * INW + (mx ? P_HG : P_GZ) + hcol);
        float gt[4] = {__uint_as_float(ug.x << 16), __uint_as_float(ug.x & 0xffff0000u), __uint_as_float(ug.y << 16), __uint_as_float(ug.y & 0xffff0000u)};
        float r[4];
#pragma unroll
        for (int k = 0; k < 4; ++k) r[k] = o[k] * rstd * gain[k] * silu_f(gt[k]);
        uint2 ov; ov.x = cvt_pk_bf16(r[0], r[1]); ov.y = cvt_pk_bf16(r[2], r[3]);
        *(uint2*)(P.hm + (size_t)row * D + (mx ? 768 : 0) + hcol) = ov;
    }
}

#ifdef DBG_STOP
__device__ void dbg_dump(const Params& P, int k) {
    for (size_t i = (size_t)blockIdx.x * 256 + threadIdx.x; i < (size_t)ML * D; i += (size_t)gridDim.x * 256) {
        const int r = (int)(i >> 10), c = (int)(i & 1023);
        float v = 0.f;
        if (k == 1 || k == 5) v = bf2f(P.hm[(size_t)r * D + c]) + ((r < MC) ? bf2f(P.hm[(size_t)(ML + r) * D + c]) : 0.f);
        else if (k == 2 || k == 3) v = bf2f(P.p[(size_t)r * INW + c * 3]) + bf2f(P.p[(size_t)r * INW + c * 3 + 272]) + ((r < MC) ? bf2f(P.p[(size_t)(ML + r) * INW + c * 3]) : 0.f)
                                     + ((k == 3) ? bf2f(P.vt[(size_t)r * 2304 + c * 2]) : 0.f);
        else if (k == 4) v = (c >= 256 && c < 768) ? bf2f(P.hm[(size_t)r * D + c]) : bf2f(P.r2[((size_t)(c >> 8) * MT + r) * 256 + (c & 255)]) + bf2f(P.r2[((size_t)((c >> 8) + 1) * MT + r) * 256 + (c & 255)]);
        else if (k == 6) v = ((const float*)P.p)[(size_t)r * D + c];
        else if (k == 7) v = P.out[i] + bf2f(P.hm[(size_t)r * D + c]);
        else if (k == 8) v = bf2f(P.p[(size_t)r * FF + c * 2]) + bf2f(P.p[(size_t)r * FF + c + 1700]);
        else if (k == 9) v = bf2f(P.r2[(size_t)r * D + c]);
        else if (k == 0) v = (c < 864 ? P.mod[(size_t)(r % 18) * NMOD + (r / 18) * 6 % 5000 + c] : 0.f) + bf2f(P.w_inT[(size_t)(r % INP) * D + c]) + bf2f(P.w_upT[(size_t)(r % FF2) * D + c]) + bf2f(P.w_downT[(size_t)(r % D) * FF + c * 2]) + bf2f(P.w_outT[(size_t)(r % D) * D + c]);
        if (k != 7) P.out[i] = v; else P.out[i] = v;
    }
}
#define DBG_CHECK(k, l) if (DBG_STOP == (k) && (l) == DBG_LAYER) { dbg_dump(P, k); return; }
#else
#define DBG_CHECK(k, l)
#endif

__global__ void __launch_bounds__(256, 2) mega(Params P) {
    extern __shared__ __attribute__((aligned(16))) char lds[];
    __shared__ uint4 xb_words;
    __shared__ int s_item;
    cg::grid_group grid = cg::this_grid();
    const int tid = threadIdx.x, wid = tid >> 6, lane = tid & 63;
    if (tid == 0) xb_words = make_uint4(0u, 0u, 0u, 0u);
    __syncthreads();
    XcdBarrier xb = xcd_barrier_post(P.bar, (volatile LAS unsigned*)&xb_words);

    for (int it = blockIdx.x; it < 864 + ADA_ITEMS; it += gridDim.x) {
        if (it < ADA_ITEMS) ada_item(P, it, (float*)lds); else convert_item(P, 0, it - ADA_ITEMS, (float*)lds);
    }
    if (P.bar == nullptr) grid.sync();
    xcd_barrier(xb);
    DBG_CHECK(0, 0)
    resnorm_phase(P, 0, 0, MT);
    xcd_barrier(xb);
    DBG_CHECK(1, 0)

    for (int layer = 0; layer < 2; ++layer) {
        const bool with_ctx = layer == 0;
        const int Mrows = with_ctx ? MT : ML;
#ifndef NO_G1
        gemm_phase<EPI_P>(P.hm, D, MT, P.w_inT, D, INP / 128, P.p, INW, INW, lds);
#endif
        xcd_barrier(xb);
        DBG_CHECK(2, layer)
        { float cwr[24];
          const float* cwp = P.gdn_conv_w + (size_t)layer * 3 * 768 + (lane >> 5) * 256 + (lane & 31) * 8;
#pragma unroll
          for (int q = 0; q < 8; ++q) { cwr[q] = cwp[q]; cwr[8 + q] = cwp[768 + q]; cwr[16 + q] = cwp[1536 + q]; }
          for (int it = blockIdx.x; it < 4608; it += gridDim.x) { qkprep_rows(P, layer, it * 4 + wid, lane); gdnprep_row(P, layer, it * 4 + wid, lane, cwr); } }
        for (int it = blockIdx.x; it < VT_ITEMS; it += gridDim.x) vt_item(P, it, lds);
        xcd_barrier(xb);
        DBG_CHECK(3, layer)
        {
            const int n_scan = 128, n_attn_lat = 1024, n_attn_ctx = with_ctx ? 128 : 0;
            const int n_attn = n_scan + n_attn_lat + n_attn_ctx;
            const int n_conv = (layer == 0) ? (CONV_ITEMS - 864) + 864 : (CONV_ITEMS - 864);
            const int total = n_attn + n_conv;
            unsigned* ctr = P.ctr + layer * 64;
            for (;;) {
                __syncthreads();
                if (tid == 0) s_item = (int)atomicAdd(ctr, 1u);
                __syncthreads();
                const int it = s_item;
                if (it >= total) break;
                if (it >= n_attn) { const int cidx = it - n_attn;
                    if (layer == 0) { if (cidx < CONV_ITEMS - 864) convert_item(P, 0, 864 + cidx, (float*)lds); else convert_item(P, 1, cidx - (CONV_ITEMS - 864), (float*)lds); }
                    else convert_item(P, 1, 864 + cidx, (float*)lds);
                    continue; }
                if (it < 64) {
                    gdn_chunked(P, layer, it, lds);
                } else if (it < 128) {
                    hgrn_chunked(P, layer, it - 64, lds);
                }
#ifndef NO_ATTN
                else if (it < 128 + 1024) { const int a = it - 128; const int type = a >> 9, r = a & 511; attn_item(P, layer, type, r >> 6, (r >> 5) & 1, r & 31, false, lds); }
                else { const int a = it - 1152; const int type = a >> 6, r = a & 63; attn_item(P, layer, type, r >> 3, (r >> 2) & 1, r & 3, true, lds); }
#endif
            }
        }
        xcd_barrier(xb);
        DBG_CHECK(4, layer)
        for (int row = blockIdx.x * 4 + wid; row < Mrows; row += gridDim.x * 4) scanfin_row(P, layer, row, lane);
        xcd_barrier(xb);
        DBG_CHECK(5, layer)
#ifndef NO_G2
        gemm_phase<EPI_BF16>(P.hm, D, Mrows, P.w_outT, D, D / 128, (void*)P.p, D, D, lds);
#endif
        xcd_barrier(xb);
        DBG_CHECK(6, layer)
        resnorm_phase(P, layer, 1, Mrows);
        xcd_barrier(xb);
        DBG_CHECK(7, layer)
#ifndef NO_G3
        ffnup_phase(P, layer, with_ctx, lds);
#endif
        xcd_barrier(xb);
        DBG_CHECK(8, layer)
#ifndef NO_G4
        gemm_phase<EPI_BF16>(P.p, FF, Mrows, P.w_downT, FF, D / 128, (void*)P.r2, D, D, lds);
#endif
        xcd_barrier(xb);
        DBG_CHECK(9, layer)
        resnorm_phase(P, layer, 2, Mrows);
        if (layer == 0) {
            xcd_barrier(xb);
        }
    }
}

extern "C" void kernel_launch(void* const* d_in, const int* in_sizes, int n_in, void* d_out, int out_size, void* d_ws, size_t ws_size, hipStream_t stream) {
    Params P{};
    const float* const* in = (const float* const*)d_in;
    P.x = in[0]; P.c = in[1]; P.ctx = in[2]; P.c_ctx = in[3]; P.ada_w = in[4]; P.ada_b = in[5]; P.n_pre_mix = in[6]; P.n_post_mix = in[7]; P.n_pre_ffn = in[8]; P.n_post_ffn = in[9];
    P.w_in = in[10]; P.w_out = in[11]; P.gdn_conv_w = in[12]; P.gdn_a_log = in[13]; P.gdn_dt_bias = in[14]; P.gdn_norm = in[15]; P.attn_q_norm = in[16]; P.attn_k_norm = in[17];
    P.swa_sink = in[18]; P.hgrn_lb_raw = in[19]; P.hgrn_norm = in[20]; P.ffn_w_up = in[21]; P.ffn_conv_w = in[22]; P.ffn_conv_b = in[23]; P.ffn_w_down = in[24];
    P.out = (float*)d_out;
    char* ws = (char*)d_ws; size_t off = 0;
    auto take = [&](size_t bytes) { char* p = ws + off; off += (bytes + 255) & ~(size_t)255; return p; };
    const size_t ctl_bytes = 16384 + 1024 + (size_t)2 * 9 * NMOD * 4;
    P.bar = (unsigned*)take(16384); P.ctr = (unsigned*)take(1024); P.mod = (float*)take((size_t)2 * 9 * NMOD * 4);
    const size_t ctl_total = off;
    P.w_inT = (bf16_t*)take((size_t)INP * D * 2); P.w_outT = (bf16_t*)take((size_t)D * D * 2); P.w_upT = (bf16_t*)take((size_t)FF2 * D * 2); P.w_downT = (bf16_t*)take((size_t)D * FF * 2);
    P.xc = (float*)take((size_t)MC * D * 4);
    P.hm = (bf16_t*)take((size_t)MT * D * 2);
    P.p = (bf16_t*)take((size_t)MT * INW * 2);
    P.r2 = (bf16_t*)take((size_t)MT * D * 2);
    P.vt = (bf16_t*)take((size_t)2 * 8 * 2 * 64 * VT_LD * 2);
    P.adapart = (float*)P.r2;
    P.gqk = (bf16_t*)take((size_t)MT * 512 * 2);
    (void)ctl_bytes;
    if (off > ws_size) { fprintf(stderr, "workspace too small: need %zu have %zu\n", off, ws_size); return; }
    (void)hipMemsetAsync(ws, 0, ctl_total, stream);
    static int grid_blocks = 0;
    if (!grid_blocks) {
        if (hipFuncSetAttribute((const void*)mega, hipFuncAttributeMaxDynamicSharedMemorySize, LDS_BYTES) != hipSuccess) { fprintf(stderr, "hipFuncSetAttribute failed\n"); return; }
        int dev = 0, cus = 0, per_cu = 0;
        (void)hipGetDevice(&dev);
        (void)hipDeviceGetAttribute(&cus, hipDeviceAttributeMultiprocessorCount, dev);
        (void)hipOccupancyMaxActiveBlocksPerMultiprocessor(&per_cu, (const void*)mega, 256, LDS_BYTES);
        if (per_cu > 2) per_cu = 2;
        if (per_cu < 1) per_cu = 1;
        grid_blocks = cus * per_cu;
    }
    void* args[] = {&P};
    hipError_t e = hipLaunchCooperativeKernel((const void*)mega, dim3(grid_blocks), dim3(256), args, LDS_BYTES, stream);
    if (e != hipSuccess) fprintf(stderr, "cooperative launch failed: %s (grid %d)\n", hipGetErrorString(e), grid_blocks);
}
```
